# Optimizing an MI355X kernel written in HIP

```python
import math
import jax
import jax.numpy as jnp
from jax import lax
import numpy as np

D_MODEL = 1024
BATCH = 2
SEQ = 16384
DEPTH = 2

GRID_W = 64
CTX_LEN = 256
N_MIXERS = 2
NORM_EPS = 1e-6
POS_BASE = 10000.0
GDN_HEADS = 8
GDN_DK = 128
GDN_DV = 128
GDN_CONV = 5
GDN_CHUNK = 64
GDN_QKV = GDN_HEADS * (2 * GDN_DK + GDN_DV)
GDN_Z = GDN_HEADS * GDN_DV
GDN_IN = GDN_QKV + GDN_Z + 4 * GDN_HEADS
FNET_GROUPS = 4
N_EXPERTS = 32
TOP_K = 4
D_FF = 1024
SWIGLU_LIMIT = 7.0
SWIGLU_ALPHA = 1.702
MOE_BLOCK = 256

kernel_name = 'hybrid_gdn_fnet_moe_dit'

F32 = jnp.float32


def _rmsnorm(x, gain):
    xf = x.astype(F32)
    y = xf * lax.rsqrt(jnp.mean(xf * xf, axis=-1, keepdims=True) + NORM_EPS)
    return (y * gain.astype(F32)).astype(x.dtype)


def _modulate(x, gain, shift, scale):
    return _rmsnorm(x, gain) * (1 + scale) + shift


def _adaln(cvec, w, b):
    return jnp.split(jax.nn.silu(cvec) @ w + b, 6, axis=-1)


def _sincos(pos, dim):
    half = dim // 2
    omega = 1.0 / (POS_BASE ** (jnp.arange(half, dtype=F32) / half))
    ang = pos.astype(F32)[:, None] * omega[None, :]
    return jnp.concatenate([jnp.sin(ang), jnp.cos(ang)], axis=-1)


def _grid_pos_embed(n_tok, dim):
    rows = n_tok // GRID_W
    r = jnp.repeat(jnp.arange(rows), GRID_W)
    col = jnp.tile(jnp.arange(GRID_W), rows)
    return jnp.concatenate([_sincos(r, dim // 2), _sincos(col, dim // 2)], axis=-1)


def _short_conv(u, w):
    n = u.shape[1]
    p = GDN_CONV // 2
    up = jnp.pad(u, ((0, 0), (p, p), (0, 0)))
    return sum(up[:, j:j + n] * w[j] for j in range(GDN_CONV))


def _l2norm(t):
    return t * lax.rsqrt(jnp.sum(t * t, axis=-1, keepdims=True) + NORM_EPS)


def _gdn_chunk_scan(q, k, v, g, beta, s0):
    b, h, n_tok, dk = q.shape
    dv = v.shape[-1]
    C = GDN_CHUNK
    n = n_tok // C
    q = q.reshape(b, h, n, C, dk)
    k = k.reshape(b, h, n, C, dk)
    v = v.reshape(b, h, n, C, dv)
    g = g.reshape(b, h, n, C)
    beta = beta.reshape(b, h, n, C)
    gc = jnp.cumsum(g, axis=-1)
    lower = jnp.tril(jnp.ones((C, C), bool))
    strict = jnp.tril(jnp.ones((C, C), bool), -1)
    decay = jnp.where(lower, jnp.exp(jnp.where(lower, gc[..., :, None] - gc[..., None, :], 0.0)), 0.0)
    kb = k * beta[..., None]
    a_mat = jnp.where(strict, jnp.einsum('bhncd,bhnsd->bhncs', kb, k) * decay, 0.0) + jnp.eye(C, dtype=F32)
    rhs = jnp.concatenate([v * beta[..., None], kb * jnp.exp(gc)[..., None]], axis=-1)
    sol = lax.linalg.triangular_solve(a_mat, rhs, left_side=True, lower=True, unit_diagonal=True)
    u, w = sol[..., :dv], sol[..., dv:]
    attn = jnp.where(lower, jnp.einsum('bhncd,bhnsd->bhncs', q, k) * decay, 0.0)

    def step(S, inp):
        q_i, k_i, u_i, w_i, gc_i, attn_i = inp
        v_new = u_i - jnp.einsum('bhck,bhkv->bhcv', w_i, S)
        o_i = (jnp.einsum('bhck,bhkv->bhcv', q_i * jnp.exp(gc_i)[..., None], S)
               + jnp.einsum('bhcs,bhsv->bhcv', attn_i, v_new))
        g_last = gc_i[..., -1]
        S = (S * jnp.exp(g_last)[..., None, None]
             + jnp.einsum('bhck,bhcv->bhkv', k_i * jnp.exp(g_last[..., None] - gc_i)[..., None], v_new))
        return S, o_i

    xs = tuple(jnp.moveaxis(t, 2, 0) for t in (q, k, u, w, gc, attn))
    S, o = lax.scan(step, s0, xs)
    return jnp.moveaxis(o, 0, 2).reshape(b, h, n_tok, dv), S


def _gdn_project(h, w_in, conv_w, a_log, dt_bias):
    b, n, _ = h.shape
    proj = h @ w_in
    qkv = jax.nn.silu(_short_conv(proj[..., :GDN_QKV], conv_w)).astype(F32)
    z = proj[..., GDN_QKV:GDN_QKV + GDN_Z]
    gates = proj[..., GDN_QKV + GDN_Z:].astype(F32).reshape(b, n, 4, GDN_HEADS)
    gates = jnp.transpose(gates, (2, 0, 3, 1))
    hk = GDN_HEADS * GDN_DK

    def heads(t, d):
        return jnp.transpose(t.reshape(b, n, GDN_HEADS, d), (0, 2, 1, 3))

    q = _l2norm(heads(qkv[..., :hk], GDN_DK)) * (GDN_DK ** -0.5)
    k = _l2norm(heads(qkv[..., hk:2 * hk], GDN_DK))
    v = heads(qkv[..., 2 * hk:], GDN_DV)
    beta = jax.nn.sigmoid(gates[:2])
    g = -jnp.exp(a_log.astype(F32))[:, None, :, None] * jax.nn.softplus(
        gates[2:] + dt_bias.astype(F32)[:, None, :, None])
    return q, k, v, z, beta, g


def _gdn_bidir(q, k, v, beta, g, s_fwd, s_bwd):
    o_f, s_f = _gdn_chunk_scan(q, k, v, g[0], beta[0], s_fwd)

    def fl(t):
        return jnp.flip(t, axis=2)

    o_b, s_b = _gdn_chunk_scan(fl(q), fl(k), fl(v), fl(g[1]), fl(beta[1]), s_bwd)
    return o_f + fl(o_b), s_f, s_b


def _gdn_output(o, z, onorm, w_out):
    b, hh, n, dv = o.shape
    o = jnp.transpose(o, (0, 2, 1, 3))
    o = o * lax.rsqrt(jnp.mean(o * o, axis=-1, keepdims=True) + NORM_EPS) * onorm.astype(F32)
    o = o.reshape(b, n, hh * dv) * jax.nn.silu(z.astype(F32))
    return o.astype(z.dtype) @ w_out


def _fourier_mix(h, w_out):
    b, n, d = h.shape
    hg = jnp.transpose(h.astype(F32).reshape(b, n, FNET_GROUPS, d // FNET_GROUPS), (0, 2, 1, 3))
    f = jnp.fft.fft2(hg, norm='ortho').real
    return jnp.transpose(f, (0, 2, 1, 3)).reshape(b, n, d).astype(h.dtype) @ w_out


def _moe(h, w_r, b_r, w_gu, b_gu, w_dn, b_dn):
    n_tok, d = h.shape
    logits = (h @ w_r + b_r).astype(F32)
    top_val, top_idx = lax.top_k(logits, TOP_K)
    top_w = jax.nn.softmax(top_val, axis=-1)
    n_as = n_tok * TOP_K
    flat_e = top_idx.reshape(-1)
    flat_tok = jnp.arange(n_as, dtype=jnp.int32) // TOP_K
    flat_w = top_w.reshape(-1)
    order = jnp.argsort(flat_e)
    e_sorted = flat_e[order]
    counts = jnp.bincount(flat_e, length=N_EXPERTS)
    padded = (counts + MOE_BLOCK - 1) // MOE_BLOCK * MOE_BLOCK
    pad_end = jnp.cumsum(padded)
    pad_start = pad_end - padded
    start = jnp.cumsum(counts) - counts
    dest = pad_start[e_sorted] + (jnp.arange(n_as) - start[e_sorted])
    n_blk = -(-(n_as + N_EXPERTS * (MOE_BLOCK - 1)) // MOE_BLOCK)
    n_pad = n_blk * MOE_BLOCK
    tok_buf = jnp.full((n_pad,), n_tok, jnp.int32).at[dest].set(flat_tok[order])
    w_buf = jnp.zeros((n_pad,), F32).at[dest].set(flat_w[order])
    blk_e = jnp.minimum(jnp.searchsorted(pad_end, jnp.arange(n_blk) * MOE_BLOCK, side='right'), N_EXPERTS - 1)
    h_pad = jnp.concatenate([h, jnp.zeros((1, d), h.dtype)], axis=0)
    xs = h_pad[tok_buf].reshape(n_blk, MOE_BLOCK, d)

    def expert_block(args):
        xb, e = args
        gu = xb @ w_gu[e] + b_gu[e]
        gate = jnp.minimum(gu[:, ::2], SWIGLU_LIMIT)
        up = jnp.clip(gu[:, 1::2], -SWIGLU_LIMIT, SWIGLU_LIMIT)
        glu = gate * jax.nn.sigmoid(gate * SWIGLU_ALPHA)
        return ((up + 1) * glu) @ w_dn[e] + b_dn[e]

    ys = lax.map(expert_block, (xs, blk_e)).reshape(n_pad, d)
    out = jnp.zeros((n_tok + 1, d), ys.dtype).at[tok_buf].add(ys * w_buf[:, None].astype(ys.dtype))
    return out[:n_tok]


def setup_inputs(seed: int = 0) -> dict:
    key = jax.random.key(seed)
    ks = jax.random.split(key, 24)
    n_a = (DEPTH + 1) // 2
    n_b = DEPTH // 2
    D = D_MODEL

    def nrm(k, shape, s):
        return jax.random.normal(k, shape, F32) * s

    dt = jnp.exp(jax.random.uniform(ks[10], (n_a, 2, GDN_HEADS), F32, math.log(1e-3), math.log(1e-1)))
    return {
        'x': nrm(ks[0], (BATCH, SEQ, D), 1.0),
        'c': nrm(ks[1], (BATCH, D), 1.0),
        'ctx': nrm(ks[2], (BATCH, CTX_LEN, D), 1.0),
        'c_ctx': nrm(ks[3], (D,), 1.0),
        'w_ada': nrm(ks[4], (DEPTH, D, 6 * D), 0.5 * D ** -0.5),
        'b_ada': nrm(ks[5], (DEPTH, 6 * D), 0.01),
        'g_mix': 1.0 + nrm(ks[6], (DEPTH, D), 0.02),
        'g_ffn': 1.0 + nrm(ks[7], (DEPTH, D), 0.02),
        'gdn_w_in': nrm(ks[8], (n_a, D, GDN_IN), D ** -0.5),
        'gdn_conv': nrm(ks[9], (n_a, GDN_CONV, GDN_QKV), GDN_CONV ** -0.5),
        'gdn_a_log': jnp.log(jax.random.uniform(ks[11], (n_a, 2, GDN_HEADS), F32, 1.0, 16.0)),
        'gdn_dt_bias': dt + jnp.log(-jnp.expm1(-dt)),
        'gdn_onorm': 1.0 + nrm(ks[12], (n_a, GDN_DV), 0.02),
        'gdn_w_out': nrm(ks[13], (n_a, GDN_Z, D), GDN_Z ** -0.5),
        'fnet_w_out': nrm(ks[14], (n_b, D, D), D ** -0.5),
        'moe_w_router': nrm(ks[15], (DEPTH, D, N_EXPERTS), D ** -0.5),
        'moe_b_router': nrm(ks[16], (DEPTH, N_EXPERTS), 0.01),
        'moe_w_gu': nrm(ks[17], (DEPTH, N_EXPERTS, D, 2 * D_FF), D ** -0.5),
        'moe_b_gu': nrm(ks[18], (DEPTH, N_EXPERTS, 2 * D_FF), 0.01),
        'moe_w_down': nrm(ks[19], (DEPTH, N_EXPERTS, D_FF, D), D_FF ** -0.5),
        'moe_b_down': nrm(ks[20], (DEPTH, N_EXPERTS, D), 0.01),
        'g_final': 1.0 + nrm(ks[21], (D,), 0.02),
    }


def reference(x, c, ctx, c_ctx, w_ada, b_ada, g_mix, g_ffn, gdn_w_in, gdn_conv, gdn_a_log, gdn_dt_bias,
              gdn_onorm, gdn_w_out, fnet_w_out, moe_w_router, moe_b_router, moe_w_gu, moe_b_gu,
              moe_w_down, moe_b_down, g_final):
    b, n_lat, d = x.shape
    n_ctx = ctx.shape[1]
    x = x + _grid_pos_embed(n_lat, d).astype(x.dtype)[None]
    for i in range(DEPTH):
        keep_ctx = i < DEPTH - 1
        sh, sc, gt, sh2, sc2, gt2 = [t[:, None, :] for t in _adaln(c, w_ada[i], b_ada[i])]
        csh, csc, cgt, csh2, csc2, cgt2 = _adaln(c_ctx, w_ada[i], b_ada[i])
        j = i // N_MIXERS
        h_lat = _modulate(x, g_mix[i], sh, sc)
        h_ctx = _modulate(ctx, g_mix[i], csh, csc)
        if i % N_MIXERS == 0:
            qc, kc, vc, zc, bc, gcx = _gdn_project(h_ctx, gdn_w_in[j], gdn_conv[j], gdn_a_log[j], gdn_dt_bias[j])
            s0 = jnp.zeros((b, GDN_HEADS, GDN_DK, GDN_DV), F32)
            o_c, s_f, s_b = _gdn_bidir(qc, kc, vc, bc, gcx, s0, s0)
            ql, kl, vl, zl, bl, glx = _gdn_project(h_lat, gdn_w_in[j], gdn_conv[j], gdn_a_log[j], gdn_dt_bias[j])
            o_l, _, _ = _gdn_bidir(ql, kl, vl, bl, glx, s_f, s_b)
            y_lat = _gdn_output(o_l, zl, gdn_onorm[j], gdn_w_out[j])
            if keep_ctx:
                y_ctx = _gdn_output(o_c, zc, gdn_onorm[j], gdn_w_out[j])
        else:
            y_lat = _fourier_mix(h_lat, fnet_w_out[j])
            if keep_ctx:
                y_ctx = _fourier_mix(h_ctx, fnet_w_out[j])
        x = x + gt * y_lat
        h_lat = _modulate(x, g_ffn[i], sh2, sc2)
        if keep_ctx:
            ctx = ctx + cgt * y_ctx
            h_ctx = _modulate(ctx, g_ffn[i], csh2, csc2)
            tokens = jnp.concatenate([h_ctx.reshape(-1, d), h_lat.reshape(-1, d)], axis=0)
            y = _moe(tokens, moe_w_router[i], moe_b_router[i], moe_w_gu[i], moe_b_gu[i], moe_w_down[i], moe_b_down[i])
            ctx = ctx + cgt2 * y[:b * n_ctx].reshape(b, n_ctx, d)
            x = x + gt2 * y[b * n_ctx:].reshape(b, n_lat, d)
        else:
            y = _moe(h_lat.reshape(-1, d), moe_w_router[i], moe_b_router[i], moe_w_gu[i], moe_b_gu[i], moe_w_down[i], moe_b_down[i])
            x = x + gt2 * y.reshape(b, n_lat, d)
    return _rmsnorm(x, g_final)
```

```cpp
#include <cstdio>
#include <cstdint>
#include <hip/hip_runtime.h>
namespace pg8 {
#define PG8_LAS __attribute__((address_space(3)))
typedef unsigned short bf16_t;
typedef short bf16x8 __attribute__((ext_vector_type(8)));
typedef float f32x4 __attribute__((ext_vector_type(4)));
typedef unsigned u32x4 __attribute__((ext_vector_type(4)));
constexpr int BM = 256, BK = 64, HALF = 128, HTB = HALF * BK * 2  , STAGE_BYTES = 8 * HTB, NXCD = 8, WGM = 8;

__host__ __device__ __forceinline__ int lds_byte(int r, int c) { const int st = (r >> 4) * 2 + (c >> 5), rr = r & 15, cc = c & 31, ob = rr * 64 + cc * 2; return st * 1024 + (ob ^ (((ob >> 9) & 1) << 5)); }
__host__ __device__ __forceinline__ void stage_rc(int b, int& R, int& C) { const int st = b / 1024, sb = b % 1024, swz = sb ^ (((sb >> 9) & 1) << 5); R = (st >> 1) * 16 + swz / 64; C = (st & 1) * 32 + (swz % 64) / 2; }
__host__ __device__ __forceinline__ int perm32(int rho) { const int n = rho >> 4, i = rho & 15; return 8 * (i >> 2) + 4 * n + (i & 3); }

struct Unit { int pm, pn; };
struct Gemm { const bf16_t* A; const bf16_t* Bt; int M, N, K; };

struct StaticOrder {
    int nM, nN, nwg, G, c;
    __host__ __device__ void init(int M, int N, int G_, int c_) { nM = M / BM; nN = N / BM; nwg = nM * nN; G = G_; c = c_; }
    __host__ __device__ bool next(int i, Unit& u) const {
        const long L = (long)i * G + c; if (L >= nwg) return false;
        int wgid = (int)L; { const int q = nwg / NXCD, r = nwg % NXCD, xcd = wgid % NXCD, off = wgid / NXCD; wgid = (xcd < r ? xcd * (q + 1) : r * (q + 1) + (xcd - r) * q) + off; }
        const int nig = WGM * nN, gid = wgid / nig, fm = gid * WGM, gsz = (nM - fm) < WGM ? (nM - fm) : WGM;
        u.pm = fm + ((wgid % nig) % gsz); u.pn = (wgid % nig) / gsz; return true;
    }
    __device__ __forceinline__ void a_ready(const Unit&) const {}
    __device__ __forceinline__ void done(const Unit&) const {}
};
struct CountedOrder : StaticOrder {
    const unsigned* ready; unsigned need; unsigned* tmo;
    __device__ __forceinline__ void a_ready(const Unit& u) const {
        if (threadIdx.x < 64) {
            const unsigned long long t0 = __builtin_amdgcn_s_memrealtime(); unsigned polls = 0;
            while ((unsigned)__builtin_amdgcn_readfirstlane(__hip_atomic_load(ready + 64 * u.pm, __ATOMIC_RELAXED, __HIP_MEMORY_SCOPE_AGENT)) < need) {
                if ((++polls & 255u) == 0u && __builtin_amdgcn_readfirstlane(__hip_atomic_load(tmo, __ATOMIC_RELAXED, __HIP_MEMORY_SCOPE_AGENT)) != 0u) break;
                if (__builtin_amdgcn_s_memrealtime() - t0 > 2000000ull) {
                    if (threadIdx.x == 0) { unsigned expect = 0u; __hip_atomic_compare_exchange_strong(tmo + 1, &expect, 0x600u | (unsigned)(u.pm & 0xff), __ATOMIC_RELAXED, __ATOMIC_RELAXED, __HIP_MEMORY_SCOPE_AGENT); __hip_atomic_store(tmo, 1u, __ATOMIC_RELAXED, __HIP_MEMORY_SCOPE_AGENT); }
                    break; }
                __builtin_amdgcn_s_sleep(2); }
            __builtin_amdgcn_fence(__ATOMIC_ACQUIRE, "agent");
            asm volatile("s_waitcnt vmcnt(0)" ::: "memory");
        }
#if !defined(BROKEN_HOOK_NO_BARRIER)
        asm volatile("" ::: "memory"); __builtin_amdgcn_s_barrier(); asm volatile("" ::: "memory");
#endif
    }
};

__device__ __forceinline__ unsigned cvt_pk_bf16(float lo, float hi) { unsigned r; asm volatile("v_cvt_pk_bf16_f32 %0, %1, %2" : "=v"(r) : "v"(lo), "v"(hi)); return r; }
typedef float f32x2 __attribute__((ext_vector_type(2)));
__device__ __forceinline__ f32x2 gelu_pk(f32x2 v) {
    const f32x2 av = __builtin_elementwise_abs(v), d = av * 0.2316418882f + 1.0f;
    f32x2 t; t.x = __builtin_amdgcn_rcpf(d.x); t.y = __builtin_amdgcn_rcpf(d.y);
    f32x2 q = t * 0.5307027145f + (-0.7265760135f); q = q * t + 0.7107068705f; q = q * t + (-0.142248368f); q = q * t + 0.127414796f; q = q * t;
    const f32x2 s = (v * v) * (-0.72134752044f);
    f32x2 e; e.x = __builtin_amdgcn_exp2f(s.x); e.y = __builtin_amdgcn_exp2f(s.y);
    const f32x2 m = v * (q * e), r = v - m;
    f32x2 o; o.x = v.x < 0.f ? m.x : r.x; o.y = v.y < 0.f ? m.y : r.y; return o;
}

struct EpiF32 {
    static constexpr bool PERM = false, AFTER_DRAIN = false;
    float* C; int ldc; const float* bias;
    __device__ __forceinline__ void operator()(const f32x4 (&acc)[2][2][4][2], const Unit& u, int wr, int wc, int fr, int fq) const {
        const int row0 = u.pm * BM + wr * 64 + fr, col0 = u.pn * BM + wc * 32 + 4 * fq;
        f32x4 bv[2][2];
#pragma unroll
        for (int bj = 0; bj < 2; ++bj)
#pragma unroll
            for (int n = 0; n < 2; ++n) bv[bj][n] = bias ? *(const f32x4*)(bias + col0 + bj * HALF + n * 16) : (f32x4){0.f, 0.f, 0.f, 0.f};
#pragma unroll
        for (int ai = 0; ai < 2; ++ai)
#pragma unroll
            for (int m = 0; m < 4; ++m) { float* rowp = C + (size_t)(row0 + ai * HALF + m * 16) * ldc + col0;
#pragma unroll
                for (int bj = 0; bj < 2; ++bj)
#pragma unroll
                    for (int n = 0; n < 2; ++n) *(f32x4*)(rowp + bj * HALF + n * 16) = acc[ai][bj][m][n] + bv[bj][n]; }
    }
};
template <int ACT  > struct EpiBf16 {
    static constexpr bool PERM = true, AFTER_DRAIN = false;
    bf16_t* O; int ldc; const float* bias; int split_cols; size_t split_stride;
    __device__ __forceinline__ void operator()(const f32x4 (&acc)[2][2][4][2], const Unit& u, int wr, int wc, int fr, int fq) const {
        const int row0 = u.pm * BM + wr * 64 + fr; int colt = u.pn * BM; bf16_t* base = O;
        if (split_cols) { const int t = colt / split_cols; base += (size_t)t * split_stride; colt -= t * split_cols; }
        const int col0 = colt + wc * 32 + 8 * fq, bcol0 = u.pn * BM + wc * 32 + 8 * fq;
        f32x4 bv[2][2];
#pragma unroll
        for (int bj = 0; bj < 2; ++bj)
#pragma unroll
            for (int n = 0; n < 2; ++n) bv[bj][n] = bias ? *(const f32x4*)(bias + bcol0 + bj * HALF + 4 * n) : (f32x4){0.f, 0.f, 0.f, 0.f};
#pragma unroll
        for (int ai = 0; ai < 2; ++ai)
#pragma unroll
            for (int m = 0; m < 4; ++m) { bf16_t* rowp = base + (size_t)(row0 + ai * HALF + m * 16) * ldc + col0;
#pragma unroll
                for (int bj = 0; bj < 2; ++bj) { f32x4 v0 = acc[ai][bj][m][0] + bv[bj][0], v1 = acc[ai][bj][m][1] + bv[bj][1];
                    if (ACT == 1) { f32x2 a = gelu_pk((f32x2){v0[0], v0[1]}), b = gelu_pk((f32x2){v0[2], v0[3]}), c = gelu_pk((f32x2){v1[0], v1[1]}), d = gelu_pk((f32x2){v1[2], v1[3]});
                        v0 = (f32x4){a.x, a.y, b.x, b.y}; v1 = (f32x4){c.x, c.y, d.x, d.y}; }
                    if (ACT == 2) {
#pragma unroll
                        for (int j = 0; j < 4; ++j) { v0[j] = 0.5f * v0[j] * (1.0f + erff(v0[j] * 0.70710678f)); v1[j] = 0.5f * v1[j] * (1.0f + erff(v1[j] * 0.70710678f)); } }
                    u32x4 w; w.x = cvt_pk_bf16(v0[0], v0[1]); w.y = cvt_pk_bf16(v0[2], v0[3]); w.z = cvt_pk_bf16(v1[0], v1[1]); w.w = cvt_pk_bf16(v1[2], v1[3]);
                    *(u32x4*)(rowp + bj * HALF) = w; } }
    }
};

template <class Epi, class Sched, bool STAMP = false>
__device__ __forceinline__ void gemm_phase(PG8_LAS unsigned char* lds, const Gemm g, const Sched& S, const Epi& E, unsigned long long* stamps) {
    const int tid = threadIdx.x, wid = __builtin_amdgcn_readfirstlane(tid >> 6), lane = tid & 63, wr = wid >> 2, wc = wid & 3, fr = lane & 15, fq = lane >> 4;
    const int K = g.K, nt = K / BK;
    int ts_lo = 0, ts_hi = 0, nts = 0; const unsigned long long rt_entry = STAMP ? (unsigned long long)wall_clock64() : 0ull;
#define PG8_STAMP() do { if (STAMP && wid == 0 && nts < 64) { const unsigned long long _c = (unsigned long long)clock64(); \
        ts_lo = (lane == nts) ? (int)(unsigned)_c : ts_lo; ts_hi = (lane == nts) ? (int)(unsigned)(_c >> 32) : ts_hi; ++nts; } } while (0)
    PG8_STAMP();
    unsigned voffA[2], voffB[2];
#pragma unroll
    for (int i = 0; i < 2; ++i) { int R, C; stage_rc(tid * 16 + i * 8192, R, C); const int Rb = Epi::PERM ? ((R & ~31) + perm32(R & 31)) : R;
        voffA[i] = (unsigned)(R * K + C) * 2u; voffB[i] = (unsigned)(Rb * K + C) * 2u; }
    const size_t kstep = (size_t)(BK * 2);
    const size_t hstep = (size_t)HALF * K * 2;
    const size_t tstep = 2 * hstep;
    const unsigned ldsw = (unsigned)wid * 1024u;
    const int aoff = lds_byte(wr * 64 + fr, fq * 8), boff = lds_byte(wc * 32 + fr, fq * 8);
#define PG8_SA(b, h) (((b) * 2 + (h)) * HTB)
#define PG8_SB(b, h) ((4 + (b) * 2 + (h)) * HTB)
#define PG8_STAGE(bufoff, gbase, voff) do { _Pragma("unroll") for (int _i = 0; _i < 2; ++_i) \
        __builtin_amdgcn_global_load_lds((const unsigned*)((const char*)(gbase) + (voff)[_i]), (PG8_LAS unsigned*)(lds + (bufoff) + ldsw + _i * 8192), 16, 0, 0); } while (0)
#define PG8_LDA(dst, b, h) do { _Pragma("unroll") for (int m = 0; m < 4; ++m) _Pragma("unroll") for (int k = 0; k < 2; ++k) dst[m][k] = *(const PG8_LAS bf16x8*)(lds + PG8_SA(b, h) + aoff + m * 2048 + k * 1024); } while (0)
#define PG8_LDB(dst, b, h) do { _Pragma("unroll") for (int n = 0; n < 2; ++n) _Pragma("unroll") for (int k = 0; k < 2; ++k) dst[n][k] = *(const PG8_LAS bf16x8*)(lds + PG8_SB(b, h) + boff + n * 2048 + k * 1024); } while (0)
#define PG8_MMA(ai, bj, At, Bt) do { __builtin_amdgcn_s_setprio(1); _Pragma("unroll") for (int m = 0; m < 4; ++m) _Pragma("unroll") for (int n = 0; n < 2; ++n) _Pragma("unroll") for (int k = 0; k < 2; ++k) \
        acc[ai][bj][m][n] = __builtin_amdgcn_mfma_f32_16x16x32_bf16(Bt[n][k], At[m][k], acc[ai][bj][m][n], 0, 0, 0); __builtin_amdgcn_s_setprio(0); } while (0)
#define PG8_WAIT_V(n) asm volatile("s_waitcnt vmcnt(" #n ")" ::: "memory")
#define PG8_WAIT_L(n) asm volatile("s_waitcnt lgkmcnt(" #n ")" ::: "memory")
#define PG8_BAR __builtin_amdgcn_s_barrier()
#define PG8_SCHED __builtin_amdgcn_sched_barrier(0)
    Unit cur, nxt; int ui = 0;
    if (!S.next(0, cur)) return;
    f32x4 acc[2][2][4][2];
#pragma unroll
    for (int a = 0; a < 2; ++a)
#pragma unroll
        for (int b = 0; b < 2; ++b)
#pragma unroll
            for (int m = 0; m < 4; ++m)
#pragma unroll
                for (int n = 0; n < 2; ++n) acc[a][b][m][n] = (f32x4){0.f, 0.f, 0.f, 0.f};
    bf16x8 At[4][2], B0[2][2], B1[2][2];
    const char* cA = (const char*)g.A + (size_t)cur.pm * tstep; const char* cB = (const char*)g.Bt + (size_t)cur.pn * tstep;
    S.a_ready(cur);
    PG8_STAGE(PG8_SB(0, 0), cB, voffB); PG8_STAGE(PG8_SA(0, 0), cA, voffA); PG8_STAGE(PG8_SB(0, 1), cB + hstep, voffB); PG8_STAGE(PG8_SA(0, 1), cA + hstep, voffA);
    if (wr == 1) PG8_BAR;
    PG8_WAIT_V(4); PG8_BAR;
    PG8_STAGE(PG8_SB(1, 0), cB + kstep, voffB); PG8_STAGE(PG8_SA(1, 0), cA + kstep, voffA); PG8_STAGE(PG8_SB(1, 1), cB + hstep + kstep, voffB);
    PG8_WAIT_V(6); PG8_BAR;
    PG8_STAMP();
    for (;;) {
        const bool has_next = S.next(ui + 1, nxt);
        const char* nA = has_next ? (const char*)g.A + (size_t)nxt.pm * tstep : cA; const char* nB = has_next ? (const char*)g.Bt + (size_t)nxt.pn * tstep : cB;
        for (int t = 0; t < nt; t += 2) {
            const bool last = (t == nt - 2);
            const char* a1 = cA + (size_t)(t + 1) * kstep;
            const char* a2 = last ? nA : cA + (size_t)(t + 2) * kstep; const char* b2 = last ? nB : cB + (size_t)(t + 2) * kstep;
            const char* a3 = a2 + kstep; const char* b3 = b2 + kstep;
            if (last && has_next) S.a_ready(nxt);
            PG8_LDB(B0, 0, 0); PG8_SCHED; PG8_LDA(At, 0, 0); PG8_STAGE(PG8_SA(1, 1), a1 + hstep, voffA);
            PG8_WAIT_L(8); PG8_BAR; PG8_WAIT_L(0); PG8_MMA(0, 0, At, B0); PG8_BAR; PG8_SCHED;
            PG8_LDB(B1, 0, 1); PG8_STAGE(PG8_SB(0, 0), b2, voffB);
            PG8_BAR; PG8_WAIT_L(0); PG8_MMA(0, 1, At, B1); PG8_BAR;
            PG8_LDA(At, 0, 1); PG8_STAGE(PG8_SA(0, 0), a2, voffA);
            PG8_BAR; PG8_WAIT_L(0); PG8_MMA(1, 0, At, B0); PG8_BAR; PG8_SCHED;
            PG8_STAGE(PG8_SB(0, 1), b2 + hstep, voffB);
            PG8_WAIT_V(6); PG8_BAR; PG8_MMA(1, 1, At, B1); PG8_BAR;
            PG8_LDB(B0, 1, 0); PG8_SCHED; PG8_LDA(At, 1, 0); PG8_STAGE(PG8_SA(0, 1), a2 + hstep, voffA);
            PG8_WAIT_L(8); PG8_BAR; PG8_WAIT_L(0); PG8_MMA(0, 0, At, B0); PG8_BAR; PG8_SCHED;
            PG8_LDB(B1, 1, 1); PG8_STAGE(PG8_SB(1, 0), b3, voffB);
            PG8_BAR; PG8_WAIT_L(0); PG8_MMA(0, 1, At, B1); PG8_BAR;
            PG8_LDA(At, 1, 1); PG8_STAGE(PG8_SA(1, 0), a3, voffA);
            PG8_BAR; PG8_WAIT_L(0); PG8_MMA(1, 0, At, B0); PG8_BAR; PG8_SCHED;
            PG8_STAGE(PG8_SB(1, 1), b3 + hstep, voffB);
            PG8_WAIT_V(6); PG8_BAR; PG8_MMA(1, 1, At, B1); PG8_BAR;
        }
        PG8_STAMP();
        if constexpr (!Epi::AFTER_DRAIN) { E(acc, cur, wr, wc, fr, fq); S.done(cur); }
        PG8_STAMP();
        if (!has_next) break;
#pragma unroll
        for (int a = 0; a < 2; ++a)
#pragma unroll
            for (int b = 0; b < 2; ++b)
#pragma unroll
                for (int m = 0; m < 4; ++m)
#pragma unroll
                    for (int n = 0; n < 2; ++n) acc[a][b][m][n] = (f32x4){0.f, 0.f, 0.f, 0.f};
        cur = nxt; cA = nA; cB = nB; ++ui;
    }
    PG8_WAIT_V(0);
    if (wr == 0) PG8_BAR;
    PG8_BAR;
    if constexpr (Epi::AFTER_DRAIN) { E.fused(acc, cur, wr, wc, fr, fq, lds, wid, lane); S.done(cur); }
    PG8_STAMP();
    if (STAMP && wid == 0) { stamps[lane] = lane < nts ? (((unsigned long long)(unsigned)ts_hi << 32) | (unsigned)ts_lo) : 0ull;
        if (lane == 62) stamps[62] = rt_entry; if (lane == 63) stamps[63] = (unsigned long long)wall_clock64(); }
#undef PG8_STAMP
#undef PG8_SA
#undef PG8_SB
#undef PG8_STAGE
#undef PG8_LDA
#undef PG8_LDB
#undef PG8_MMA
#undef PG8_WAIT_V
#undef PG8_WAIT_L
#undef PG8_BAR
#undef PG8_SCHED
}
}
#define XB_TMO      128
#define XB_XCNT(j)  (256  + 64 * (j))
#define XB_XSUB(j)  (1280 + 64 * (j))
#define XB_XGEN(j)  (2304 + 64 * (j))
#define XB_TOP      3328
#define XB_TOPGEN   3392
#define XCD_BAR_WORDS 3456
#define XB_SPIN_CAP (1u << 18)
#define LAS __attribute__((address_space(3)))

__device__ __forceinline__ unsigned xb_ld(unsigned* p)              { return __hip_atomic_load(p, __ATOMIC_RELAXED, __HIP_MEMORY_SCOPE_AGENT); }
__device__ __forceinline__ unsigned xb_add(unsigned* p, unsigned v) { return __hip_atomic_fetch_add(p, v, __ATOMIC_RELAXED, __HIP_MEMORY_SCOPE_AGENT); }
__device__ __forceinline__ unsigned xb_xcc_id() { return (unsigned)__builtin_amdgcn_s_getreg((3 << 11) | 20) & 0xFu; }
#define XB_SPIN(cond, bar) do { unsigned _sp = 0; while (cond) { __builtin_amdgcn_s_sleep(1); \
    if ((++_sp & 255u) == 0u) { if (xb_ld(&(bar)[XB_TMO])) break; if (_sp > XB_SPIN_CAP) { atomicAdd(&(bar)[XB_TMO], 1u); break; } } } } while (0)

struct XcdBarrier {
    unsigned* bar; unsigned x;
    volatile LAS unsigned* st;
};

__device__ __forceinline__ XcdBarrier xcd_barrier_post(unsigned* bar, volatile LAS unsigned* st) {
    XcdBarrier b; b.bar = bar; b.x = xb_xcc_id(); b.st = st;
    if (threadIdx.x == 0) (void)xb_add(&bar[XB_XCNT(b.x)], 1u);
    return b;
}
__device__ __forceinline__ void xcd_barrier_complete(unsigned* bar, unsigned x, unsigned& nloc, unsigned& nx) {
    const unsigned G = gridDim.x * gridDim.y * gridDim.z;
    unsigned sum, cnt, mine, sp = 0u;
    for (;;) {
        sum = 0u; cnt = 0u; mine = 0u;
#pragma unroll
        for (unsigned j = 0; j < 16; ++j) { const unsigned c = xb_ld(&bar[XB_XCNT(j)]); sum += c; cnt += (c > 0u) ? 1u : 0u; mine = (j == x) ? c : mine; }
        if (sum == G) break;
        __builtin_amdgcn_s_sleep(1);
        if ((++sp & 255u) == 0u) { if (xb_ld(&bar[XB_TMO])) break; if (sp > XB_SPIN_CAP) { atomicAdd(&bar[XB_TMO], 1u); break; } }
    }
    nloc = mine > 0u ? mine : 1u; nx = cnt > 0u ? cnt : 1u;
}

__device__ __forceinline__ void xcd_barrier(const XcdBarrier& b) {
    asm volatile("s_waitcnt vmcnt(0)" ::: "memory");
    __syncthreads();
    if (threadIdx.x == 0) {
        unsigned* bar = b.bar;
        __builtin_amdgcn_s_waitcnt(0);
        unsigned nloc = b.st[0], nx = b.st[1];
        if (nloc == 0u) { xcd_barrier_complete(bar, b.x, nloc, nx); b.st[0] = nloc; b.st[1] = nx; }
        const unsigned old = xb_add(&bar[XB_XSUB(b.x)], 1u);
        const unsigned gen = old / nloc;
        if (old + 1u == (gen + 1u) * nloc) {
            __builtin_amdgcn_fence(__ATOMIC_RELEASE, "agent");
            asm volatile("s_waitcnt vmcnt(0)" ::: "memory");
            const unsigned og = xb_add(&bar[XB_TOP], 1u);
            const unsigned tg = og / nx;
            if (og + 1u == (tg + 1u) * nx) xb_add(&bar[XB_TOPGEN], 1u);
            else XB_SPIN(xb_ld(&bar[XB_TOPGEN]) == tg, bar);
            __builtin_amdgcn_fence(__ATOMIC_ACQUIRE, "agent");
            xb_add(&bar[XB_XGEN(b.x)], 1u);
            asm volatile("s_waitcnt vmcnt(0)" ::: "memory");
        } else {
            XB_SPIN(xb_ld(&bar[XB_XGEN(b.x)]) == gen, bar);
            __builtin_amdgcn_fence(__ATOMIC_ACQUIRE, "agent");
            asm volatile("s_waitcnt vmcnt(0)" ::: "memory");
        }
    }
    __syncthreads();
}

typedef unsigned short bf16_t;
typedef float f32x4 __attribute__((ext_vector_type(4)));
typedef float f32x2v __attribute__((ext_vector_type(2)));
typedef unsigned u32x4 __attribute__((ext_vector_type(4)));
typedef unsigned u32x2 __attribute__((ext_vector_type(2)));

constexpr int D = 1024, NB = 2, SEQ = 16384, NCTX = 256;
constexpr int NL = NB * SEQ;
constexpr int NCT = NB * NCTX;
constexpr int TALL = NL + NCT;
constexpr int NH = 8, DK = 128;
constexpr int QKVC = 3072, GIN = 4128, GINP = 4352;
constexpr int NE = 32, DFF = 1024;
constexpr int MAXROWS = NL * 4 + NE * 256;
constexpr int NTHR = 512;
constexpr int LDS_BYTES = 144 * 1024;
constexpr int LDS_MISC = 128 * 1024;

constexpr size_t AL(size_t x) { return (x + 255) & ~(size_t)255; }
constexpr size_t WS_CTL   = 0;                               constexpr size_t CTL_BYTES = 65536;
constexpr size_t CTL_CNT  = 16384;
constexpr size_t WS_MOD   = WS_CTL + CTL_BYTES;
constexpr size_t WS_POSR  = AL(WS_MOD + 2 * 3 * 6144 * 4);
constexpr size_t WS_POSC  = AL(WS_POSR + 256 * 512 * 4);
constexpr size_t WS_TILEE = AL(WS_POSC + 64 * 512 * 4);
constexpr size_t WS_BTIN  = AL(WS_TILEE + 2 * 1024 * 4);
constexpr size_t WS_BTOUT = AL(WS_BTIN + (size_t)GINP * 1024 * 2);
constexpr size_t WS_BTFN  = AL(WS_BTOUT + (size_t)1024 * 1024 * 2);
constexpr size_t WS_BTGU  = AL(WS_BTFN + (size_t)1024 * 2048 * 2);
constexpr size_t WS_BTDN  = AL(WS_BTGU + (size_t)2 * 32 * 2048 * 1024 * 2);
constexpr size_t WS_X0    = AL(WS_BTDN + (size_t)2 * 32 * 1024 * 1024 * 2);
constexpr size_t WS_HB    = AL(WS_X0 + (size_t)NL * 1024 * 4);
constexpr size_t WS_TOPE  = AL(WS_HB + (size_t)TALL * 1024 * 2);
constexpr size_t WS_TOPW  = AL(WS_TOPE + (size_t)NL * 16);
constexpr size_t WS_SLOT  = AL(WS_TOPW + (size_t)NL * 16);
constexpr size_t WS_POS   = AL(WS_SLOT + (size_t)NL * 16);
constexpr size_t WS_SCR   = AL(WS_POS + (size_t)NL * 16);
constexpr size_t WS_PROJ  = WS_SCR;
constexpr size_t WS_GATES = AL(WS_PROJ + (size_t)TALL * 4096 * 2);
constexpr size_t WS_QKVF  = AL(WS_GATES + (size_t)TALL * 32 * 4);
constexpr size_t WS_BETA  = AL(WS_QKVF + (size_t)TALL * 3072 * 4);
constexpr size_t WS_GG    = AL(WS_BETA + (size_t)2 * TALL * 8 * 4);
constexpr size_t WS_OF    = AL(WS_GG + (size_t)2 * TALL * 8 * 4);
constexpr size_t WS_OB    = AL(WS_OF + (size_t)NL * 1024 * 4);
constexpr size_t WS_GDN_END = AL(WS_OB + (size_t)NL * 1024 * 4);
constexpr size_t WS_XS    = WS_SCR;
constexpr size_t WS_ACT   = AL(WS_XS + (size_t)MAXROWS * 1024 * 2);
constexpr size_t WS_MOE_END = AL(WS_ACT + (size_t)MAXROWS * 1024 * 2);
constexpr size_t WS_YR    = WS_SCR;
constexpr size_t WS_YI    = AL(WS_YR + (size_t)NL * 1024 * 4);
constexpr size_t WS_XCAT  = AL(WS_YI + (size_t)NL * 1024 * 4);
constexpr size_t WS_FN_END = AL(WS_XCAT + (size_t)NL * 2048 * 2);
constexpr size_t WS_END = WS_GDN_END > WS_MOE_END ? (WS_GDN_END > WS_FN_END ? WS_GDN_END : WS_FN_END) : (WS_MOE_END > WS_FN_END ? WS_MOE_END : WS_FN_END);

struct Args {
    const float* x; const float* c; const float* ctx; const float* c_ctx; const float* w_ada; const float* b_ada; const float* g_mix; const float* g_ffn;
    const float* gdn_w_in; const float* gdn_conv; const float* gdn_a_log; const float* gdn_dt_bias; const float* gdn_onorm; const float* gdn_w_out; const float* fnet_w_out;
    const float* moe_w_router; const float* moe_b_router; const float* moe_w_gu; const float* moe_b_gu; const float* moe_w_down; const float* moe_b_down; const float* g_final;
    float* out; unsigned char* ws; int ph_lo, ph_hi;
};

__device__ __forceinline__ unsigned short f2bf(float f) { unsigned u = __float_as_uint(f); u += 0x7fffu + ((u >> 16) & 1u); return (unsigned short)(u >> 16); }
__device__ __forceinline__ float bf2f(unsigned short h) { return __uint_as_float((unsigned)h << 16); }
__device__ __forceinline__ unsigned pack2(float a, float b) { return (unsigned)f2bf(a) | ((unsigned)f2bf(b) << 16); }
__device__ __forceinline__ float bflo(unsigned w) { return __uint_as_float(w << 16); }
__device__ __forceinline__ float bfhi(unsigned w) { return __uint_as_float(w & 0xffff0000u); }
__device__ __forceinline__ float wave_sum(float v) {
#pragma unroll
    for (int o = 32; o >= 1; o >>= 1) v += __shfl_xor(v, o);
    return v;
}
__device__ __forceinline__ float silu_f(float x) { return x / (1.f + __expf(-x)); }
__device__ __forceinline__ float sigmoid_f(float x) { return 1.f / (1.f + __expf(-x)); }

struct EpiProj {
    static constexpr bool PERM = true, AFTER_DRAIN = false;
    bf16_t* P; float* Gt;
    __device__ __forceinline__ void operator()(const f32x4 (&acc)[2][2][4][2], const pg8::Unit& u, int wr, int wc, int fr, int fq) const {
        const int row0 = u.pm * 256 + wr * 64 + fr;
        if (u.pn < 16) {
            const int col0 = u.pn * 256 + wc * 32 + 8 * fq;
#pragma unroll
            for (int ai = 0; ai < 2; ++ai)
#pragma unroll
                for (int m = 0; m < 4; ++m) { bf16_t* rowp = P + (size_t)(row0 + ai * 128 + m * 16) * 4096 + col0;
#pragma unroll
                    for (int bj = 0; bj < 2; ++bj) { const f32x4 v0 = acc[ai][bj][m][0], v1 = acc[ai][bj][m][1];
                        u32x4 w; w.x = pg8::cvt_pk_bf16(v0[0], v0[1]); w.y = pg8::cvt_pk_bf16(v0[2], v0[3]); w.z = pg8::cvt_pk_bf16(v1[0], v1[1]); w.w = pg8::cvt_pk_bf16(v1[2], v1[3]);
                        *(u32x4*)(rowp + bj * 128) = w; } }
        } else if (wc == 0) {
#pragma unroll
            for (int ai = 0; ai < 2; ++ai)
#pragma unroll
                for (int m = 0; m < 4; ++m) { float* gp = Gt + (size_t)(row0 + ai * 128 + m * 16) * 32 + 8 * fq;
                    *(f32x4*)gp = acc[ai][0][m][0]; *(f32x4*)(gp + 4) = acc[ai][0][m][1]; }
        }
    }
};
struct EpiResid {
    static constexpr bool PERM = false, AFTER_DRAIN = false;
    float* X; const float* gate;
    __device__ __forceinline__ void operator()(const f32x4 (&acc)[2][2][4][2], const pg8::Unit& u, int wr, int wc, int fr, int fq) const {
        const int row0 = u.pm * 256 + wr * 64 + fr, col0 = u.pn * 256 + wc * 32 + 4 * fq;
#pragma unroll
        for (int ai = 0; ai < 2; ++ai)
#pragma unroll
            for (int m = 0; m < 4; ++m) { const int r = row0 + ai * 128 + m * 16; const float* gp = gate + (size_t)(r >> 14) * 6144 + col0; float* xp = X + (size_t)r * 1024 + col0;
#pragma unroll
                for (int bj = 0; bj < 2; ++bj)
#pragma unroll
                    for (int n = 0; n < 2; ++n) { const int c = bj * 128 + n * 16; const f32x4 gv = *(const f32x4*)(gp + c); f32x4 xv = *(const f32x4*)(xp + c); xv = xv + gv * acc[ai][bj][m][n]; *(f32x4*)(xp + c) = xv; } }
    }
};
struct EpiGLU {
    static constexpr bool PERM = true, AFTER_DRAIN = false;
    bf16_t* ACT; const float* bgu;
    __device__ __forceinline__ void operator()(const f32x4 (&acc)[2][2][4][2], const pg8::Unit& u, int wr, int wc, int fr, int fq) const {
        const int e = u.pn >> 3, ct = u.pn & 7; const int row0 = u.pm * 256 + wr * 64 + fr; const int j0 = ct * 128 + wc * 32 + 8 * fq;
        const float* bp = bgu + (size_t)e * 2048 + 2 * j0;
        f32x4 b0 = *(const f32x4*)(bp), b1 = *(const f32x4*)(bp + 4), b2 = *(const f32x4*)(bp + 8), b3 = *(const f32x4*)(bp + 12);
        const float bg[8] = {b0[0], b0[2], b1[0], b1[2], b2[0], b2[2], b3[0], b3[2]}, bu[8] = {b0[1], b0[3], b1[1], b1[3], b2[1], b2[3], b3[1], b3[3]};
#pragma unroll
        for (int ai = 0; ai < 2; ++ai)
#pragma unroll
            for (int m = 0; m < 4; ++m) { float a[8];
#pragma unroll
                for (int n = 0; n < 2; ++n)
#pragma unroll
                    for (int i = 0; i < 4; ++i) { float gt = acc[ai][0][m][n][i] + bg[n * 4 + i], up = acc[ai][1][m][n][i] + bu[n * 4 + i];
                        gt = fminf(gt, 7.0f); up = fminf(fmaxf(up, -7.0f), 7.0f);
                        const float glu = gt / (1.f + __expf(-1.702f * gt)); a[n * 4 + i] = (up + 1.f) * glu; }
                u32x4 w; w.x = pg8::cvt_pk_bf16(a[0], a[1]); w.y = pg8::cvt_pk_bf16(a[2], a[3]); w.z = pg8::cvt_pk_bf16(a[4], a[5]); w.w = pg8::cvt_pk_bf16(a[6], a[7]);
                *(u32x4*)(ACT + (size_t)(row0 + ai * 128 + m * 16) * 1024 + j0) = w; }
    }
};
struct EpiDown {
    static constexpr bool PERM = true, AFTER_DRAIN = false;
    bf16_t* YS; const float* bdn;
    __device__ __forceinline__ void operator()(const f32x4 (&acc)[2][2][4][2], const pg8::Unit& u, int wr, int wc, int fr, int fq) const {
        const int e = u.pn >> 2, ct = u.pn & 3; const int row0 = u.pm * 256 + wr * 64 + fr; const int col0 = ct * 256 + wc * 32 + 8 * fq;
        const float* bp = bdn + (size_t)e * 1024 + col0;
        f32x4 bv[2][2];
#pragma unroll
        for (int bj = 0; bj < 2; ++bj)
#pragma unroll
            for (int n = 0; n < 2; ++n) bv[bj][n] = *(const f32x4*)(bp + bj * 128 + 4 * n);
#pragma unroll
        for (int ai = 0; ai < 2; ++ai)
#pragma unroll
            for (int m = 0; m < 4; ++m) { bf16_t* rowp = YS + (size_t)(row0 + ai * 128 + m * 16) * 1024 + col0;
#pragma unroll
                for (int bj = 0; bj < 2; ++bj) { const f32x4 v0 = acc[ai][bj][m][0] + bv[bj][0], v1 = acc[ai][bj][m][1] + bv[bj][1];
                    u32x4 w; w.x = pg8::cvt_pk_bf16(v0[0], v0[1]); w.y = pg8::cvt_pk_bf16(v0[2], v0[3]); w.z = pg8::cvt_pk_bf16(v1[0], v1[1]); w.w = pg8::cvt_pk_bf16(v1[2], v1[3]);
                    *(u32x4*)(rowp + bj * 128) = w; } }
    }
};
struct MoeOrder {
    int G, c, nN, ntiles; const int* tile_e;
    __device__ __forceinline__ bool next(int i, pg8::Unit& u) const {
        const long L = (long)i * G + c; const int rt = (int)(L / nN), ct = (int)(L % nN);
        if (rt >= ntiles) return false;
        u.pm = rt; u.pn = tile_e[rt] * nN + ct; return true;
    }
    __device__ __forceinline__ void a_ready(const pg8::Unit&) const {}
    __device__ __forceinline__ void done(const pg8::Unit&) const {}
};

#define LDSF(off) ((float*)(lds + (off)))

template <class RM> __device__ __forceinline__ void cvt_tile(const float* __restrict__ src, int ldsrc, int nsrc, bf16_t* __restrict__ dst, int lddst, int k0, int n0, float* tile, RM rm) {
    const int t = threadIdx.x; const int nn = t & 127, kq = t >> 7;
#pragma unroll
    for (int i = 0; i < 16; ++i) { const int kk = kq + 4 * i; tile[kk * 129 + nn] = (n0 + nn < nsrc) ? src[(size_t)(k0 + kk) * ldsrc + n0 + nn] : 0.f; }
    __syncthreads();
#pragma unroll
    for (int i = 0; i < 2; ++i) { const int item = t + 512 * i; const int g8 = item & 7, n2 = item >> 3;
        if (n0 + n2 < nsrc) { float v[8];
#pragma unroll
            for (int j = 0; j < 8; ++j) v[j] = tile[(8 * g8 + j) * 129 + n2];
            u32x4 w; w.x = pack2(v[0], v[1]); w.y = pack2(v[2], v[3]); w.z = pack2(v[4], v[5]); w.w = pack2(v[6], v[7]);
            *(u32x4*)(dst + (size_t)rm(n0 + n2) * lddst + k0 + 8 * g8) = w; } }
    __syncthreads();
}
struct RMId { __device__ __forceinline__ int operator()(int n) const { return n; } };
struct RMGu { __device__ __forceinline__ int operator()(int n) const { const int j = n >> 1; return (j >> 7) * 256 + (j & 127) + ((n & 1) << 7); } };

__device__ __forceinline__ void p0_prologue(const Args& a, unsigned char* lds) {
    unsigned char* ws = a.ws; const int t = threadIdx.x; const int G = gridDim.x;
    float* MOD = (float*)(ws + WS_MOD);
    constexpr int U_ADA = 2 * 192, U_POS = 320, U_WIN = 16 * 33, U_WINZ = 7, U_WOUT = 16 * 8, U_GU = 64 * 256, U_DN = 64 * 128, U_FN = 256;
    constexpr int O_POS = U_ADA, O_WIN = O_POS + U_POS, O_WINZ = O_WIN + U_WIN, O_WOUT = O_WINZ + U_WINZ, O_GU = O_WOUT + U_WOUT, O_DN = O_GU + U_GU, O_FN = O_DN + U_DN, U_ALL = O_FN + U_FN;
    float* tile = LDSF(0);
    for (int u = blockIdx.x; u < U_ALL; u += G) {
        if (u < O_POS) {
            const int l = u / 192, cb = u % 192; float* sv = LDSF(0);
            for (int i = t; i < 3 * 1024; i += NTHR) { const int v = i >> 10, k = i & 1023; const float cv = v < 2 ? a.c[v * 1024 + k] : a.c_ctx[k]; sv[i] = silu_f(cv); }
            __syncthreads();
            const int col = t & 31, kp = t >> 5; const float* wp = a.w_ada + (size_t)l * 1024 * 6144 + cb * 32 + col;
            float s0 = 0.f, s1 = 0.f, s2 = 0.f;
            for (int k = kp; k < 1024; k += 16) { const float w = wp[(size_t)k * 6144]; s0 += sv[k] * w; s1 += sv[1024 + k] * w; s2 += sv[2048 + k] * w; }
            float* red = LDSF(16384);
            red[(0 * 16 + kp) * 32 + col] = s0; red[(1 * 16 + kp) * 32 + col] = s1; red[(2 * 16 + kp) * 32 + col] = s2;
            __syncthreads();
            if (t < 96) { const int v = t >> 5, cc = t & 31; float s = 0.f; for (int k = 0; k < 16; ++k) s += red[(v * 16 + k) * 32 + cc];
                MOD[((size_t)l * 3 + v) * 6144 + cb * 32 + cc] = s + a.b_ada[l * 6144 + cb * 32 + cc]; }
            __syncthreads();
        } else if (u < O_WIN) {
            const int r = u - O_POS; const int p = r < 256 ? r : r - 256; float* dstp = (float*)(ws + (r < 256 ? WS_POSR : WS_POSC)) + (size_t)p * 512;
            const int i = t & 255; const double om = pow(10000.0, -(double)i / 256.0); const double ang = (double)p * om;
            dstp[t] = (float)(t < 256 ? sin(ang) : cos(ang));
        } else if (u < O_WINZ) {
            const int q = u - O_WIN; cvt_tile(a.gdn_w_in, GIN, GIN, (bf16_t*)(ws + WS_BTIN), 1024, (q / 33) * 64, (q % 33) * 128, tile, RMId());
        } else if (u < O_WOUT) {
            const int q = u - O_WINZ; u32x4* p = (u32x4*)((bf16_t*)(ws + WS_BTIN) + (size_t)(GIN + q * 32) * 1024);
            for (int i = t; i < 32 * 1024 / 8; i += NTHR) p[i] = (u32x4){0u, 0u, 0u, 0u};
        } else if (u < O_GU) {
            const int q = u - O_WOUT; cvt_tile(a.gdn_w_out, 1024, 1024, (bf16_t*)(ws + WS_BTOUT), 1024, (q / 8) * 64, (q % 8) * 128, tile, RMId());
        } else if (u < O_DN) {
            const int q = u - O_GU; const int le = q >> 8, tt = q & 255;
            cvt_tile(a.moe_w_gu + (size_t)le * 1024 * 2048, 2048, 2048, (bf16_t*)(ws + WS_BTGU) + (size_t)le * 2048 * 1024, 1024, (tt >> 4) * 64, (tt & 15) * 128, tile, RMGu());
        } else if (u < O_FN) {
            const int q = u - O_DN; const int le = q >> 7, tt = q & 127;
            cvt_tile(a.moe_w_down + (size_t)le * 1024 * 1024, 1024, 1024, (bf16_t*)(ws + WS_BTDN) + (size_t)le * 1024 * 1024, 1024, (tt >> 3) * 64, (tt & 7) * 128, tile, RMId());
        } else {
            const int q = u - O_FN; const int kk0 = q * 8; const int part = kk0 >> 10, g = (kk0 >> 8) & 3, c0 = kk0 & 255;
            float* trg = LDSF(0);
            if (t < 256) { const double ang = 6.283185307179586476925 * (double)t / 256.0; trg[t] = (float)(part ? sin(ang) : cos(ang)); }
            __syncthreads();
            float acc[2][8];
#pragma unroll
            for (int jj = 0; jj < 2; ++jj)
#pragma unroll
                for (int k = 0; k < 8; ++k) acc[jj][k] = 0.f;
            const float* wf = a.fnet_w_out + (size_t)(g * 256) * 1024;
            for (int l = 0; l < 256; ++l) { const float w0 = wf[(size_t)l * 1024 + t], w1 = wf[(size_t)l * 1024 + t + 512];
#pragma unroll
                for (int k = 0; k < 8; ++k) { const float tr = trg[(l * (c0 + k)) & 255]; acc[0][k] += tr * w0; acc[1][k] += tr * w1; } }
            bf16_t* bt = (bf16_t*)(ws + WS_BTFN);
#pragma unroll
            for (int jj = 0; jj < 2; ++jj) { const float s = 1.0f / 2048.0f; u32x4 w; w.x = pack2(acc[jj][0] * s, acc[jj][1] * s); w.y = pack2(acc[jj][2] * s, acc[jj][3] * s); w.z = pack2(acc[jj][4] * s, acc[jj][5] * s); w.w = pack2(acc[jj][6] * s, acc[jj][7] * s);
                *(u32x4*)(bt + (size_t)(t + 512 * jj) * 2048 + kk0) = w; }
            __syncthreads();
        }
    }
}

__device__ __forceinline__ void p1_embed(const Args& a) {
    unsigned char* ws = a.ws; const int lane = threadIdx.x & 63, wv = threadIdx.x >> 6;
    const float* MOD = (const float*)(ws + WS_MOD); const float* POSR = (const float*)(ws + WS_POSR); const float* POSC = (const float*)(ws + WS_POSC);
    float* X0 = (float*)(ws + WS_X0); bf16_t* HB = (bf16_t*)(ws + WS_HB);
    for (int r = blockIdx.x * 8 + wv; r < TALL; r += gridDim.x * 8) {
        f32x4 xv[4]; const float* mv; float ss = 0.f;
        if (r < NCT) { const float* src = a.ctx + (size_t)r * 1024; mv = MOD + 2 * 6144;
#pragma unroll
            for (int i = 0; i < 4; ++i) xv[i] = *(const f32x4*)(src + i * 256 + lane * 4);
        } else { const int n = r - NCT; const int b = n >> 14, tt = n & 16383; const float* src = a.x + (size_t)n * 1024; mv = MOD + b * 6144;
            const float* pr = POSR + (size_t)(tt >> 6) * 512; const float* pc = POSC + (size_t)(tt & 63) * 512;
#pragma unroll
            for (int i = 0; i < 4; ++i) { const int c = i * 256 + lane * 4; const f32x4 pv = c < 512 ? *(const f32x4*)(pr + c) : *(const f32x4*)(pc + c - 512); xv[i] = *(const f32x4*)(src + c) + pv;
                *(f32x4*)(X0 + (size_t)n * 1024 + c) = xv[i]; }
        }
#pragma unroll
        for (int i = 0; i < 4; ++i) ss += xv[i][0] * xv[i][0] + xv[i][1] * xv[i][1] + xv[i][2] * xv[i][2] + xv[i][3] * xv[i][3];
        ss = wave_sum(ss); const float rstd = rsqrtf(ss * (1.0f / 1024.0f) + 1e-6f);
#pragma unroll
        for (int i = 0; i < 4; ++i) { const int c = i * 256 + lane * 4; const f32x4 gm = *(const f32x4*)(a.g_mix + c), sh = *(const f32x4*)(mv + c), sc = *(const f32x4*)(mv + 1024 + c);
            const f32x4 hv = xv[i] * rstd * gm * (sc + 1.0f) + sh; u32x2 w; w.x = pack2(hv[0], hv[1]); w.y = pack2(hv[2], hv[3]); *(u32x2*)(HB + (size_t)r * 1024 + c) = w; }
    }
}

__device__ __forceinline__ void p3_conv(const Args& a) {
    unsigned char* ws = a.ws; const int lane = threadIdx.x & 63, wv = threadIdx.x >> 6;
    const bf16_t* PROJ = (const bf16_t*)(ws + WS_PROJ); const float* GATES = (const float*)(ws + WS_GATES);
    float* QKVF = (float*)(ws + WS_QKVF); float* BETA = (float*)(ws + WS_BETA); float* GG = (float*)(ws + WS_GG);
    const long nitems = (long)TALL * 24;
    for (long it = (long)blockIdx.x * 8 + wv; it < nitems; it += (long)gridDim.x * 8) {
        const int r = (int)(it / 24), s = (int)(it % 24); int lo, hi;
        if (r < NCT) { lo = (r >> 8) << 8; hi = lo + 256; } else { const int n = r - NCT; lo = NCT + ((n >> 14) << 14); hi = lo + 16384; }
        const int col = s * 128 + lane * 2; float a0 = 0.f, a1 = 0.f;
#pragma unroll
        for (int j = 0; j < 5; ++j) { const int rr = r + j - 2;
            if (rr >= lo && rr < hi) { const unsigned pw = *(const unsigned*)(PROJ + (size_t)rr * 4096 + col); const f32x2v w = *(const f32x2v*)(a.gdn_conv + j * 3072 + col);
                a0 += bflo(pw) * w[0]; a1 += bfhi(pw) * w[1]; } }
        a0 = silu_f(a0); a1 = silu_f(a1);
        if (s < 16) { const float ss = wave_sum(a0 * a0 + a1 * a1); const float sc = rsqrtf(ss + 1e-6f) * (s < 8 ? 0.08838834764831845f : 1.0f); a0 *= sc; a1 *= sc; }
        *(f32x2v*)(QKVF + (size_t)r * 3072 + col) = (f32x2v){a0, a1};
    }
    for (long i = (long)blockIdx.x * NTHR + threadIdx.x; i < (long)TALL * 16; i += (long)gridDim.x * NTHR) {
        const int r = (int)(i >> 4), q = (int)(i & 15); const int d = q >> 3, hh = q & 7;
        const float gb = GATES[(size_t)r * 32 + q], ga = GATES[(size_t)r * 32 + 16 + q];
        const float xx = ga + a.gdn_dt_bias[q]; const float sp = xx > 20.f ? xx : log1pf(expf(xx));
        BETA[((size_t)d * TALL + r) * 8 + hh] = 1.f / (1.f + expf(-gb));
        GG[((size_t)d * TALL + r) * 8 + hh] = -expf(a.gdn_a_log[q]) * sp;
    }
}

__device__ __forceinline__ void p4_scan_naive(const Args& a) {
    unsigned char* ws = a.ws; const int lane = threadIdx.x & 63, wv = threadIdx.x >> 6;
    if (wv != 0) return;
    const float* QKVF = (const float*)(ws + WS_QKVF); const float* BETA = (const float*)(ws + WS_BETA); const float* GG = (const float*)(ws + WS_GG);
    const int ip = lane >> 4, j = lane & 15;
    for (int item = blockIdx.x; item < 256; item += gridDim.x) {
        const int chain = item >> 3, sl = item & 7; const int b = chain >> 4, hh = (chain >> 1) & 7, dir = chain & 1;
        float* O = (float*)(ws + (dir ? WS_OB : WS_OF));
        float S[32];
#pragma unroll
        for (int i = 0; i < 32; ++i) S[i] = 0.f;
        for (int seg = 0; seg < 2; ++seg) {
            const int len = seg ? SEQ : NCTX; const int base = seg ? NCT + b * SEQ : b * NCTX;
            f32x4 kn[8], qn[8]; float vn, bn, gn;
            { const int r = base + (dir ? len - 1 : 0); const float* qp = QKVF + (size_t)r * 3072 + hh * 128 + ip * 32;
#pragma unroll
              for (int i = 0; i < 8; ++i) { qn[i] = *(const f32x4*)(qp + 4 * i); kn[i] = *(const f32x4*)(qp + 1024 + 4 * i); }
              vn = QKVF[(size_t)r * 3072 + 2048 + hh * 128 + sl * 16 + j]; bn = BETA[((size_t)dir * TALL + r) * 8 + hh]; gn = GG[((size_t)dir * TALL + r) * 8 + hh]; }
            for (int i = 0; i < len; ++i) {
                const int r = base + (dir ? len - 1 - i : i);
                f32x4 kc[8], qc[8];
#pragma unroll
                for (int q = 0; q < 8; ++q) { kc[q] = kn[q]; qc[q] = qn[q]; }
                const float vc = vn, bc = bn, eg = __expf(gn);
                if (i + 1 < len) { const int r2 = base + (dir ? len - 2 - i : i + 1); const float* qp = QKVF + (size_t)r2 * 3072 + hh * 128 + ip * 32;
#pragma unroll
                    for (int q = 0; q < 8; ++q) { qn[q] = *(const f32x4*)(qp + 4 * q); kn[q] = *(const f32x4*)(qp + 1024 + 4 * q); }
                    vn = QKVF[(size_t)r2 * 3072 + 2048 + hh * 128 + sl * 16 + j]; bn = BETA[((size_t)dir * TALL + r2) * 8 + hh]; gn = GG[((size_t)dir * TALL + r2) * 8 + hh]; }
                float rp = 0.f;
#pragma unroll
                for (int q = 0; q < 8; ++q)
#pragma unroll
                    for (int e = 0; e < 4; ++e) { S[q * 4 + e] *= eg; rp += kc[q][e] * S[q * 4 + e]; }
                rp += __shfl_xor(rp, 16); rp += __shfl_xor(rp, 32);
                const float dlt = bc * (vc - rp); float op = 0.f;
#pragma unroll
                for (int q = 0; q < 8; ++q)
#pragma unroll
                    for (int e = 0; e < 4; ++e) { S[q * 4 + e] += kc[q][e] * dlt; op += qc[q][e] * S[q * 4 + e]; }
                op += __shfl_xor(op, 16); op += __shfl_xor(op, 32);
                if (seg && ip == 0) O[(size_t)(r - NCT) * 1024 + hh * 128 + sl * 16 + j] = op;
            }
        }
    }
}

__device__ __forceinline__ void p5_gdn_out(const Args& a) {
    unsigned char* ws = a.ws; const int lane = threadIdx.x & 63, wv = threadIdx.x >> 6;
    const float* OF = (const float*)(ws + WS_OF); const float* OB = (const float*)(ws + WS_OB); const bf16_t* PROJ = (const bf16_t*)(ws + WS_PROJ); bf16_t* HB = (bf16_t*)(ws + WS_HB);
    const f32x2v on = *(const f32x2v*)(a.gdn_onorm + lane * 2);
    for (long it = (long)blockIdx.x * 8 + wv; it < (long)NL * 8; it += (long)gridDim.x * 8) {
        const int n = (int)(it >> 3), hh = (int)(it & 7); const size_t off = (size_t)n * 1024 + hh * 128 + lane * 2;
        const f32x2v of = *(const f32x2v*)(OF + off), ob = *(const f32x2v*)(OB + off); float o0 = of[0] + ob[0], o1 = of[1] + ob[1];
        const float ms = wave_sum(o0 * o0 + o1 * o1) * (1.0f / 128.0f); const float rs = rsqrtf(ms + 1e-6f);
        const unsigned zw = *(const unsigned*)(PROJ + (size_t)(NCT + n) * 4096 + 3072 + hh * 128 + lane * 2);
        o0 = o0 * rs * on[0] * silu_f(bflo(zw)); o1 = o1 * rs * on[1] * silu_f(bfhi(zw));
        *(unsigned*)(HB + off) = pack2(o0, o1);
    }
}

template <int L> __device__ __forceinline__ void p7_router(const Args& a, unsigned char* lds) {
    unsigned char* ws = a.ws; const int t = threadIdx.x, lane = t & 63, wv = t >> 6;
    const float* MOD = (const float*)(ws + WS_MOD) + (size_t)L * 3 * 6144; const float* X0 = (const float*)(ws + WS_X0); bf16_t* HB = (bf16_t*)(ws + WS_HB);
    int* TOPE = (int*)(ws + WS_TOPE); float* TOPW = (float*)(ws + WS_TOPW); int* SLOT = (int*)(ws + WS_SLOT); int* CNT = (int*)(ws + WS_CTL + CTL_CNT) + L * 32;
    const float* gf = a.g_ffn + L * 1024; const float* wr = a.moe_w_router + (size_t)L * 1024 * 32; const float* br = a.moe_b_router + L * 32;
    float* hrow = LDSF(0) + wv * 1024;
    int* lcnt = (int*)(lds + 65536); int* gbase = lcnt + 32; int* tokE = gbase + 32; int* tokS = tokE + 512; float* tokW = (float*)(tokS + 512);
    for (int u = blockIdx.x; u < NL / 128; u += gridDim.x) {
        if (t < 32) lcnt[t] = 0;
        __syncthreads();
        for (int tt = 0; tt < 16; ++tt) {
            const int tl = wv * 16 + tt; const int n = u * 128 + tl; const int b = n >> 14; const float* mv = MOD + b * 6144;
            f32x4 xv[4]; float ss = 0.f;
#pragma unroll
            for (int i = 0; i < 4; ++i) { xv[i] = *(const f32x4*)(X0 + (size_t)n * 1024 + i * 256 + lane * 4); ss += xv[i][0] * xv[i][0] + xv[i][1] * xv[i][1] + xv[i][2] * xv[i][2] + xv[i][3] * xv[i][3]; }
            ss = wave_sum(ss); const float rstd = rsqrtf(ss * (1.0f / 1024.0f) + 1e-6f);
#pragma unroll
            for (int i = 0; i < 4; ++i) { const int c = i * 256 + lane * 4; const f32x4 gm = *(const f32x4*)(gf + c), sh = *(const f32x4*)(mv + 3072 + c), sc = *(const f32x4*)(mv + 4096 + c);
                const f32x4 hv = xv[i] * rstd * gm * (sc + 1.0f) + sh; u32x2 w; w.x = pack2(hv[0], hv[1]); w.y = pack2(hv[2], hv[3]); *(u32x2*)(HB + (size_t)n * 1024 + c) = w;
                *(f32x4*)(hrow + c) = hv; }
            asm volatile("s_waitcnt lgkmcnt(0)" ::: "memory");
            const int e = lane & 31, half = lane >> 5; const float* hp = hrow + half * 512; const float* wp = wr + (size_t)(half * 512) * 32 + e;
            float acc = 0.f;
#pragma unroll 8
            for (int i = 0; i < 512; ++i) acc += hp[i] * wp[(size_t)i * 32];
            acc += __shfl_xor(acc, 32);
            float val = acc + br[e];
            int selE[4]; float selV[4];
#pragma unroll
            for (int k = 0; k < 4; ++k) { float bv = val; int bi = e;
#pragma unroll
                for (int o = 1; o <= 16; o <<= 1) { const float ov = __shfl_xor(bv, o); const int oi = __shfl_xor(bi, o); if (ov > bv || (ov == bv && oi < bi)) { bv = ov; bi = oi; } }
                selE[k] = bi; selV[k] = bv; if (e == bi) val = -3.0e38f; }
            asm volatile("s_waitcnt lgkmcnt(0)" ::: "memory");
            if (lane == 0) { const float e1 = __expf(selV[1] - selV[0]), e2 = __expf(selV[2] - selV[0]), e3 = __expf(selV[3] - selV[0]); const float inv = 1.f / (1.f + e1 + e2 + e3);
                const float wk[4] = {inv, e1 * inv, e2 * inv, e3 * inv};
#pragma unroll
                for (int k = 0; k < 4; ++k) { tokE[tl * 4 + k] = selE[k]; tokW[tl * 4 + k] = wk[k]; tokS[tl * 4 + k] = atomicAdd(&lcnt[selE[k]], 1); } }
        }
        __syncthreads();
        if (t < 32) gbase[t] = atomicAdd(&CNT[t], lcnt[t]);
        __syncthreads();
        { const int tl = t >> 2; const int n = u * 128 + tl; const int e = tokE[t]; TOPE[(size_t)n * 4 + (t & 3)] = e; TOPW[(size_t)n * 4 + (t & 3)] = tokW[t]; SLOT[(size_t)n * 4 + (t & 3)] = gbase[e] + tokS[t]; }
        __syncthreads();
    }
}

template <int L> __device__ __forceinline__ void p8_gather(const Args& a, unsigned char* lds) {
    unsigned char* ws = a.ws; const int t = threadIdx.x, lane = t & 63, wv = t >> 6;
    const int* CNT = (const int*)(ws + WS_CTL + CTL_CNT) + L * 32; int* TE = (int*)(ws + WS_TILEE) + L * 1024;
    const int* TOPE = (const int*)(ws + WS_TOPE); const int* SLOT = (const int*)(ws + WS_SLOT); int* POS = (int*)(ws + WS_POS);
    const bf16_t* HB = (const bf16_t*)(ws + WS_HB); bf16_t* XS = (bf16_t*)(ws + WS_XS);
    int* rb = (int*)lds;
    if (t == 0) { int acc = 0; for (int e = 0; e < 32; ++e) { const int c = CNT[e]; const int nt = (c + 255) >> 8; rb[e] = acc * 256; rb[32 + e] = nt;
            if (blockIdx.x == 0) { for (int q = 0; q < nt; ++q) TE[16 + acc + q] = e; } acc += nt; }
        if (blockIdx.x == 0) TE[0] = acc; }
    __syncthreads();
    for (int n = blockIdx.x * 8 + wv; n < NL; n += gridDim.x * 8) {
        const u32x4 v0 = *(const u32x4*)(HB + (size_t)n * 1024 + lane * 8), v1 = *(const u32x4*)(HB + (size_t)n * 1024 + 512 + lane * 8);
#pragma unroll
        for (int k = 0; k < 4; ++k) { const int e = TOPE[(size_t)n * 4 + k]; const int row = rb[e] + SLOT[(size_t)n * 4 + k];
            *(u32x4*)(XS + (size_t)row * 1024 + lane * 8) = v0; *(u32x4*)(XS + (size_t)row * 1024 + 512 + lane * 8) = v1;
            if (lane == 0) POS[(size_t)n * 4 + k] = row; }
    }
    __syncthreads();
}

template <int L> __device__ __forceinline__ void p11_combine(const Args& a) {
    unsigned char* ws = a.ws; const int lane = threadIdx.x & 63, wv = threadIdx.x >> 6;
    const float* MOD = (const float*)(ws + WS_MOD); float* X0 = (float*)(ws + WS_X0); bf16_t* HB = (bf16_t*)(ws + WS_HB);
    const bf16_t* YS = (const bf16_t*)(ws + WS_XS); const int* POS = (const int*)(ws + WS_POS); const float* TOPW = (const float*)(ws + WS_TOPW);
    for (int n = blockIdx.x * 8 + wv; n < NL; n += gridDim.x * 8) {
        const int b = n >> 14; const float* mvL = MOD + ((size_t)L * 3 + b) * 6144;
        int rows[4]; float wk[4];
#pragma unroll
        for (int k = 0; k < 4; ++k) { rows[k] = POS[(size_t)n * 4 + k]; wk[k] = TOPW[(size_t)n * 4 + k]; }
        f32x4 xv[4]; float ss = 0.f;
#pragma unroll
        for (int i = 0; i < 4; ++i) { const int c = i * 256 + lane * 4; f32x4 y = (f32x4){0.f, 0.f, 0.f, 0.f};
#pragma unroll
            for (int k = 0; k < 4; ++k) { const u32x2 w = *(const u32x2*)(YS + (size_t)rows[k] * 1024 + c); y[0] += wk[k] * bflo(w.x); y[1] += wk[k] * bfhi(w.x); y[2] += wk[k] * bflo(w.y); y[3] += wk[k] * bfhi(w.y); }
            const f32x4 g2 = *(const f32x4*)(mvL + 5 * 1024 + c); xv[i] = *(const f32x4*)(X0 + (size_t)n * 1024 + c) + g2 * y;
            ss += xv[i][0] * xv[i][0] + xv[i][1] * xv[i][1] + xv[i][2] * xv[i][2] + xv[i][3] * xv[i][3]; }
        ss = wave_sum(ss); const float rstd = rsqrtf(ss * (1.0f / 1024.0f) + 1e-6f);
        if (L == 0) { const float* mv1 = MOD + ((size_t)3 + b) * 6144;
#pragma unroll
            for (int i = 0; i < 4; ++i) { const int c = i * 256 + lane * 4; *(f32x4*)(X0 + (size_t)n * 1024 + c) = xv[i];
                const f32x4 gm = *(const f32x4*)(a.g_mix + 1024 + c), sh = *(const f32x4*)(mv1 + c), sc = *(const f32x4*)(mv1 + 1024 + c);
                const f32x4 hv = xv[i] * rstd * gm * (sc + 1.0f) + sh; u32x2 w; w.x = pack2(hv[0], hv[1]); w.y = pack2(hv[2], hv[3]); *(u32x2*)(HB + (size_t)n * 1024 + c) = w; }
        } else {
#pragma unroll
            for (int i = 0; i < 4; ++i) { const int c = i * 256 + lane * 4; const f32x4 gm = *(const f32x4*)(a.g_final + c); *(f32x4*)(a.out + (size_t)n * 1024 + c) = xv[i] * rstd * gm; }
        }
    }
}

__device__ __forceinline__ void p12_f1_naive(const Args& a, unsigned char* lds) {
    unsigned char* ws = a.ws; const int t = threadIdx.x; const bf16_t* HB = (const bf16_t*)(ws + WS_HB); float* YR = (float*)(ws + WS_YR); float* YI = (float*)(ws + WS_YI);
    bf16_t* hs = (bf16_t*)lds;
    float* cs = LDSF(LDS_MISC), * sn = cs + 128;
    if (t < 128) { const double ang = 6.283185307179586476925 * (double)t / 128.0; cs[t] = (float)cos(ang); sn[t] = (float)sin(ang); }
    __syncthreads();
    for (int u = blockIdx.x; u < 1024; u += gridDim.x) {
        const int b = u >> 9, n2 = (u >> 2) & 127, cb = u & 3;
#pragma unroll
        for (int i = 0; i < 8; ++i) { const int idx = t + 512 * i; const int n1 = idx >> 5, p = idx & 31;
            *(u32x4*)(hs + n1 * 256 + p * 8) = *(const u32x4*)(HB + (size_t)(b * SEQ + 128 * n1 + n2) * 1024 + cb * 256 + p * 8); }
        __syncthreads();
        const int c = t & 255, kh = t >> 8;
        for (int kb = 0; kb < 8; ++kb) { float ar[8], ai[8];
#pragma unroll
            for (int q = 0; q < 8; ++q) { ar[q] = 0.f; ai[q] = 0.f; }
            const int k1b = kh * 64 + kb * 8;
            for (int n1 = 0; n1 < 128; ++n1) { const float hv = bf2f(hs[n1 * 256 + c]);
#pragma unroll
                for (int q = 0; q < 8; ++q) { const int m = ((k1b + q) * n1) & 127; ar[q] += hv * cs[m]; ai[q] -= hv * sn[m]; } }
#pragma unroll
            for (int q = 0; q < 8; ++q) { const int k1 = k1b + q; const int m2 = n2 * k1; float tc, tsn; sincospif((float)m2 * (1.0f / 8192.0f), &tsn, &tc);
                const float yr = ar[q] * tc + ai[q] * tsn, yi = ai[q] * tc - ar[q] * tsn; const size_t o = ((size_t)(b * 128 + k1) * 128 + n2) * 1024 + cb * 256 + c; YR[o] = yr; YI[o] = yi; }
        }
        __syncthreads();
    }
}
__device__ __forceinline__ void p13_f2_naive(const Args& a, unsigned char* lds) {
    unsigned char* ws = a.ws; const int t = threadIdx.x; const float* YR = (const float*)(ws + WS_YR); const float* YI = (const float*)(ws + WS_YI); bf16_t* XC = (bf16_t*)(ws + WS_XCAT);
    float* yr = LDSF(0), * yi = LDSF(65536);
    float* cs = LDSF(LDS_MISC), * sn = cs + 128;
    if (t < 128) { const double ang = 6.283185307179586476925 * (double)t / 128.0; cs[t] = (float)cos(ang); sn[t] = (float)sin(ang); }
    __syncthreads();
    for (int u = blockIdx.x; u < 2048; u += gridDim.x) {
        const int b = u >> 10, k1 = (u >> 3) & 127, cb = u & 7;
#pragma unroll
        for (int i = 0; i < 8; ++i) { const int idx = t + 512 * i; const int n2 = idx >> 5, p = idx & 31; const size_t o = ((size_t)(b * 128 + k1) * 128 + n2) * 1024 + cb * 128 + p * 4;
            *(f32x4*)(yr + n2 * 128 + p * 4) = *(const f32x4*)(YR + o); *(f32x4*)(yi + n2 * 128 + p * 4) = *(const f32x4*)(YI + o); }
        __syncthreads();
        const int c = t & 127, kq = t >> 7;
        for (int kb = 0; kb < 4; ++kb) { float ar[8], ai[8];
#pragma unroll
            for (int q = 0; q < 8; ++q) { ar[q] = 0.f; ai[q] = 0.f; }
            const int k2b = kq * 32 + kb * 8;
            for (int n2 = 0; n2 < 128; ++n2) { const float vr = yr[n2 * 128 + c], vi = yi[n2 * 128 + c];
#pragma unroll
                for (int q = 0; q < 8; ++q) { const int m = ((k2b + q) * n2) & 127; const float cc = cs[m], s2 = sn[m]; ar[q] += vr * cc + vi * s2; ai[q] += vi * cc - vr * s2; } }
#pragma unroll
            for (int q = 0; q < 8; ++q) { const int k2 = k2b + q; const size_t row = (size_t)b * SEQ + k1 + 128 * k2; XC[row * 2048 + cb * 128 + c] = f2bf(ar[q]); XC[row * 2048 + 1024 + cb * 128 + c] = f2bf(ai[q]); }
        }
        __syncthreads();
    }
}

constexpr int NPHASE = 20;
template <int L> __device__ __forceinline__ void moe_phases(const Args& args, unsigned char* lds, int lo, int hi, int base) {
#define IN(k) (lo <= (k) && (k) < hi)
    unsigned char* ws = args.ws;
    if (IN(base + 0)) p7_router<L>(args, lds);
    if (IN(base + 1)) p8_gather<L>(args, lds);
    if (IN(base + 2)) {
        const int* TE = (const int*)(ws + WS_TILEE) + L * 1024;
        pg8::Gemm g{(const bf16_t*)(ws + WS_XS), (const bf16_t*)(ws + WS_BTGU) + (size_t)L * 32 * 2048 * 1024, MAXROWS, 2048, 1024};
        MoeOrder S{(int)gridDim.x, (int)blockIdx.x, 8, TE[0], TE + 16};
        EpiGLU E{(bf16_t*)(ws + WS_ACT), args.moe_b_gu + (size_t)L * 32 * 2048};
        pg8::gemm_phase<EpiGLU, MoeOrder, false>((PG8_LAS unsigned char*)lds, g, S, E, nullptr);
    }
    if (IN(base + 3)) {
        const int* TE = (const int*)(ws + WS_TILEE) + L * 1024;
        pg8::Gemm g{(const bf16_t*)(ws + WS_ACT), (const bf16_t*)(ws + WS_BTDN) + (size_t)L * 32 * 1024 * 1024, MAXROWS, 1024, 1024};
        MoeOrder S{(int)gridDim.x, (int)blockIdx.x, 4, TE[0], TE + 16};
        EpiDown E{(bf16_t*)(ws + WS_XS), args.moe_b_down + (size_t)L * 32 * 1024};
        pg8::gemm_phase<EpiDown, MoeOrder, false>((PG8_LAS unsigned char*)lds, g, S, E, nullptr);
    }
    if (IN(base + 4)) p11_combine<L>(args);
#undef IN
}

__global__ void __launch_bounds__(NTHR, 2) mk_fwd(Args args) {
    extern __shared__ __attribute__((aligned(16))) unsigned char lds[];
    unsigned char* ws = args.ws;
    const int lo = args.ph_lo, hi = args.ph_hi;
#define IN(k) (lo <= (k) && (k) < hi)
    if (IN(0)) p0_prologue(args, lds);
    if (IN(1)) p1_embed(args);
    if (IN(2)) {
        pg8::Gemm g{(const bf16_t*)(ws + WS_HB), (const bf16_t*)(ws + WS_BTIN), TALL, GINP, 1024};
        pg8::StaticOrder S; S.init(TALL, GINP, (int)gridDim.x, (int)blockIdx.x);
        EpiProj E{(bf16_t*)(ws + WS_PROJ), (float*)(ws + WS_GATES)};
        pg8::gemm_phase<EpiProj, pg8::StaticOrder, false>((PG8_LAS unsigned char*)lds, g, S, E, nullptr);
    }
    if (IN(3)) p3_conv(args);
    if (IN(4)) p4_scan_naive(args);
    if (IN(5)) p5_gdn_out(args);
    if (IN(6)) {
        pg8::Gemm g{(const bf16_t*)(ws + WS_HB), (const bf16_t*)(ws + WS_BTOUT), NL, 1024, 1024};
        pg8::StaticOrder S; S.init(NL, 1024, (int)gridDim.x, (int)blockIdx.x);
        EpiResid E{(float*)(ws + WS_X0), (const float*)(ws + WS_MOD) + 2048};
        pg8::gemm_phase<EpiResid, pg8::StaticOrder, false>((PG8_LAS unsigned char*)lds, g, S, E, nullptr);
    }
    moe_phases<0>(args, lds, lo, hi, 7);
    if (IN(12)) p12_f1_naive(args, lds);
    if (IN(13)) p13_f2_naive(args, lds);
    if (IN(14)) {
        pg8::Gemm g{(const bf16_t*)(ws + WS_XCAT), (const bf16_t*)(ws + WS_BTFN), NL, 1024, 2048};
        pg8::StaticOrder S; S.init(NL, 1024, (int)gridDim.x, (int)blockIdx.x);
        EpiResid E{(float*)(ws + WS_X0), (const float*)(ws + WS_MOD) + 3 * 6144 + 2048};
        pg8::gemm_phase<EpiResid, pg8::StaticOrder, false>((PG8_LAS unsigned char*)lds, g, S, E, nullptr);
    }
    moe_phases<1>(args, lds, lo, hi, 15);
#undef IN
}

extern "C" void kernel_launch(void* const* d_in, const int* in_sizes, int n_in, void* d_out, int out_size, void* d_ws, size_t ws_size, hipStream_t stream) {
    static int grid = 0;
    if (grid == 0) {
        int dev = 0, cus = 0;
        if (hipGetDevice(&dev) != hipSuccess || hipDeviceGetAttribute(&cus, hipDeviceAttributeMultiprocessorCount, dev) != hipSuccess) { fprintf(stderr, "kernel_launch: device query failed\n"); grid = -1; return; }
        if (hipFuncSetAttribute((const void*)mk_fwd, hipFuncAttributeMaxDynamicSharedMemorySize, LDS_BYTES) != hipSuccess) { fprintf(stderr, "kernel_launch: hipFuncSetAttribute failed\n"); grid = -1; return; }
        if (n_in != 22 || ws_size < WS_END) { fprintf(stderr, "kernel_launch: unexpected n_in %d or ws_size %zu < %zu\n", n_in, ws_size, (size_t)WS_END); grid = -1; return; }
        grid = cus;
    }
    if (grid < 0) return;
    (void)hipMemsetAsync((char*)d_ws + WS_CTL, 0, CTL_BYTES, stream);
    Args a{};
    const float** fp = (const float**)&a;
    for (int i = 0; i < 22; ++i) fp[i] = (const float*)d_in[i];
    a.out = (float*)d_out; a.ws = (unsigned char*)d_ws;
    for (int ph = 0; ph < NPHASE; ++ph) { a.ph_lo = ph; a.ph_hi = ph + 1; hipLaunchKernelGGL(mk_fwd, dim3(grid), dim3(NTHR), LDS_BYTES, stream, a); }
}
```

```cpp
#include <cstdio>
#include <cstdint>
#include <hip/hip_runtime.h>
namespace pg8 {
#define PG8_LAS __attribute__((address_space(3)))
typedef unsigned short bf16_t;
typedef short bf16x8 __attribute__((ext_vector_type(8)));
typedef float f32x4 __attribute__((ext_vector_type(4)));
typedef unsigned u32x4 __attribute__((ext_vector_type(4)));
constexpr int BM = 256, BK = 64, HALF = 128, HTB = HALF * BK * 2  , STAGE_BYTES = 8 * HTB, NXCD = 8, WGM = 8;

__host__ __device__ __forceinline__ int lds_byte(int r, int c) { const int st = (r >> 4) * 2 + (c >> 5), rr = r & 15, cc = c & 31, ob = rr * 64 + cc * 2; return st * 1024 + (ob ^ (((ob >> 9) & 1) << 5)); }
__host__ __device__ __forceinline__ void stage_rc(int b, int& R, int& C) { const int st = b / 1024, sb = b % 1024, swz = sb ^ (((sb >> 9) & 1) << 5); R = (st >> 1) * 16 + swz / 64; C = (st & 1) * 32 + (swz % 64) / 2; }
__host__ __device__ __forceinline__ int perm32(int rho) { const int n = rho >> 4, i = rho & 15; return 8 * (i >> 2) + 4 * n + (i & 3); }

struct Unit { int pm, pn; };
struct Gemm { const bf16_t* A; const bf16_t* Bt; int M, N, K; };

struct StaticOrder {
    int nM, nN, nwg, G, c;
    __host__ __device__ void init(int M, int N, int G_, int c_) { nM = M / BM; nN = N / BM; nwg = nM * nN; G = G_; c = c_; }
    __host__ __device__ bool next(int i, Unit& u) const {
        const long L = (long)i * G + c; if (L >= nwg) return false;
        int wgid = (int)L; { const int q = nwg / NXCD, r = nwg % NXCD, xcd = wgid % NXCD, off = wgid / NXCD; wgid = (xcd < r ? xcd * (q + 1) : r * (q + 1) + (xcd - r) * q) + off; }
        const int nig = WGM * nN, gid = wgid / nig, fm = gid * WGM, gsz = (nM - fm) < WGM ? (nM - fm) : WGM;
        u.pm = fm + ((wgid % nig) % gsz); u.pn = (wgid % nig) / gsz; return true;
    }
    __device__ __forceinline__ void a_ready(const Unit&) const {}
    __device__ __forceinline__ void done(const Unit&) const {}
};
struct CountedOrder : StaticOrder {
    const unsigned* ready; unsigned need; unsigned* tmo;
    __device__ __forceinline__ void a_ready(const Unit& u) const {
        if (threadIdx.x < 64) {
            const unsigned long long t0 = __builtin_amdgcn_s_memrealtime(); unsigned polls = 0;
            while ((unsigned)__builtin_amdgcn_readfirstlane(__hip_atomic_load(ready + 64 * u.pm, __ATOMIC_RELAXED, __HIP_MEMORY_SCOPE_AGENT)) < need) {
                if ((++polls & 255u) == 0u && __builtin_amdgcn_readfirstlane(__hip_atomic_load(tmo, __ATOMIC_RELAXED, __HIP_MEMORY_SCOPE_AGENT)) != 0u) break;
                if (__builtin_amdgcn_s_memrealtime() - t0 > 2000000ull) {
                    if (threadIdx.x == 0) { unsigned expect = 0u; __hip_atomic_compare_exchange_strong(tmo + 1, &expect, 0x600u | (unsigned)(u.pm & 0xff), __ATOMIC_RELAXED, __ATOMIC_RELAXED, __HIP_MEMORY_SCOPE_AGENT); __hip_atomic_store(tmo, 1u, __ATOMIC_RELAXED, __HIP_MEMORY_SCOPE_AGENT); }
                    break; }
                __builtin_amdgcn_s_sleep(2); }
            __builtin_amdgcn_fence(__ATOMIC_ACQUIRE, "agent");
            asm volatile("s_waitcnt vmcnt(0)" ::: "memory");
        }
#if !defined(BROKEN_HOOK_NO_BARRIER)
        asm volatile("" ::: "memory"); __builtin_amdgcn_s_barrier(); asm volatile("" ::: "memory");
#endif
    }
};

typedef float f32x2c __attribute__((ext_vector_type(2)));
typedef __bf16 bf16x2c __attribute__((ext_vector_type(2)));
__device__ __forceinline__ unsigned cvt_pk_bf16(float lo, float hi) { const f32x2c v = {lo, hi}; const bf16x2c r = __builtin_convertvector(v, bf16x2c); return __builtin_bit_cast(unsigned, r); }
typedef float f32x2 __attribute__((ext_vector_type(2)));
__device__ __forceinline__ f32x2 gelu_pk(f32x2 v) {
    const f32x2 av = __builtin_elementwise_abs(v), d = av * 0.2316418882f + 1.0f;
    f32x2 t; t.x = __builtin_amdgcn_rcpf(d.x); t.y = __builtin_amdgcn_rcpf(d.y);
    f32x2 q = t * 0.5307027145f + (-0.7265760135f); q = q * t + 0.7107068705f; q = q * t + (-0.142248368f); q = q * t + 0.127414796f; q = q * t;
    const f32x2 s = (v * v) * (-0.72134752044f);
    f32x2 e; e.x = __builtin_amdgcn_exp2f(s.x); e.y = __builtin_amdgcn_exp2f(s.y);
    const f32x2 m = v * (q * e), r = v - m;
    f32x2 o; o.x = v.x < 0.f ? m.x : r.x; o.y = v.y < 0.f ? m.y : r.y; return o;
}

struct EpiF32 {
    static constexpr bool PERM = false, AFTER_DRAIN = false, HAS_PRE = false;
    float* C; int ldc; const float* bias;
    __device__ __forceinline__ void operator()(const f32x4 (&acc)[2][2][4][2], const Unit& u, int wr, int wc, int fr, int fq) const {
        const int row0 = u.pm * BM + wr * 64 + fr, col0 = u.pn * BM + wc * 32 + 4 * fq;
        f32x4 bv[2][2];
#pragma unroll
        for (int bj = 0; bj < 2; ++bj)
#pragma unroll
            for (int n = 0; n < 2; ++n) bv[bj][n] = bias ? *(const f32x4*)(bias + col0 + bj * HALF + n * 16) : (f32x4){0.f, 0.f, 0.f, 0.f};
#pragma unroll
        for (int ai = 0; ai < 2; ++ai)
#pragma unroll
            for (int m = 0; m < 4; ++m) { float* rowp = C + (size_t)(row0 + ai * HALF + m * 16) * ldc + col0;
#pragma unroll
                for (int bj = 0; bj < 2; ++bj)
#pragma unroll
                    for (int n = 0; n < 2; ++n) *(f32x4*)(rowp + bj * HALF + n * 16) = acc[ai][bj][m][n] + bv[bj][n]; }
    }
};
template <int ACT  > struct EpiBf16 {
    static constexpr bool PERM = true, AFTER_DRAIN = false, HAS_PRE = false;
    bf16_t* O; int ldc; const float* bias; int split_cols; size_t split_stride;
    __device__ __forceinline__ void operator()(const f32x4 (&acc)[2][2][4][2], const Unit& u, int wr, int wc, int fr, int fq) const {
        const int row0 = u.pm * BM + wr * 64 + fr; int colt = u.pn * BM; bf16_t* base = O;
        if (split_cols) { const int t = colt / split_cols; base += (size_t)t * split_stride; colt -= t * split_cols; }
        const int col0 = colt + wc * 32 + 8 * fq, bcol0 = u.pn * BM + wc * 32 + 8 * fq;
        f32x4 bv[2][2];
#pragma unroll
        for (int bj = 0; bj < 2; ++bj)
#pragma unroll
            for (int n = 0; n < 2; ++n) bv[bj][n] = bias ? *(const f32x4*)(bias + bcol0 + bj * HALF + 4 * n) : (f32x4){0.f, 0.f, 0.f, 0.f};
#pragma unroll
        for (int ai = 0; ai < 2; ++ai)
#pragma unroll
            for (int m = 0; m < 4; ++m) { bf16_t* rowp = base + (size_t)(row0 + ai * HALF + m * 16) * ldc + col0;
#pragma unroll
                for (int bj = 0; bj < 2; ++bj) { f32x4 v0 = acc[ai][bj][m][0] + bv[bj][0], v1 = acc[ai][bj][m][1] + bv[bj][1];
                    if (ACT == 1) { f32x2 a = gelu_pk((f32x2){v0[0], v0[1]}), b = gelu_pk((f32x2){v0[2], v0[3]}), c = gelu_pk((f32x2){v1[0], v1[1]}), d = gelu_pk((f32x2){v1[2], v1[3]});
                        v0 = (f32x4){a.x, a.y, b.x, b.y}; v1 = (f32x4){c.x, c.y, d.x, d.y}; }
                    if (ACT == 2) {
#pragma unroll
                        for (int j = 0; j < 4; ++j) { v0[j] = 0.5f * v0[j] * (1.0f + erff(v0[j] * 0.70710678f)); v1[j] = 0.5f * v1[j] * (1.0f + erff(v1[j] * 0.70710678f)); } }
                    u32x4 w; w.x = cvt_pk_bf16(v0[0], v0[1]); w.y = cvt_pk_bf16(v0[2], v0[3]); w.z = cvt_pk_bf16(v1[0], v1[1]); w.w = cvt_pk_bf16(v1[2], v1[3]);
                    *(u32x4*)(rowp + bj * HALF) = w; } }
    }
};

template <class Epi, class Sched, bool STAMP = false>
__device__ __forceinline__ void gemm_phase(PG8_LAS unsigned char* lds, const Gemm g, const Sched& S, const Epi& E, unsigned long long* stamps) {
    const int tid = threadIdx.x, wid = __builtin_amdgcn_readfirstlane(tid >> 6), lane = tid & 63, wr = wid >> 2, wc = wid & 3, fr = lane & 15, fq = lane >> 4;
    const int K = g.K, nt = K / BK;
    int ts_lo = 0, ts_hi = 0, nts = 0; const unsigned long long rt_entry = STAMP ? (unsigned long long)wall_clock64() : 0ull;
#define PG8_STAMP() do { if (STAMP && wid == 0 && nts < 64) { const unsigned long long _c = (unsigned long long)clock64(); \
        ts_lo = (lane == nts) ? (int)(unsigned)_c : ts_lo; ts_hi = (lane == nts) ? (int)(unsigned)(_c >> 32) : ts_hi; ++nts; } } while (0)
    PG8_STAMP();
    unsigned voffA[2], voffB[2];
#pragma unroll
    for (int i = 0; i < 2; ++i) { int R, C; stage_rc(tid * 16 + i * 8192, R, C); const int Rb = Epi::PERM ? ((R & ~31) + perm32(R & 31)) : R;
        voffA[i] = (unsigned)(R * K + C) * 2u; voffB[i] = (unsigned)(Rb * K + C) * 2u; }
    const size_t kstep = (size_t)(BK * 2);
    const size_t hstep = (size_t)HALF * K * 2;
    const size_t tstep = 2 * hstep;
    const unsigned ldsw = (unsigned)wid * 1024u;
    const int aoff = lds_byte(wr * 64 + fr, fq * 8), boff = lds_byte(wc * 32 + fr, fq * 8);
#define PG8_SA(b, h) (((b) * 2 + (h)) * HTB)
#define PG8_SB(b, h) ((4 + (b) * 2 + (h)) * HTB)
#define PG8_STAGE(bufoff, gbase, voff) do { _Pragma("unroll") for (int _i = 0; _i < 2; ++_i) \
        __builtin_amdgcn_global_load_lds((const unsigned*)((const char*)(gbase) + (voff)[_i]), (PG8_LAS unsigned*)(lds + (bufoff) + ldsw + _i * 8192), 16, 0, 0); } while (0)
#define PG8_LDA(dst, b, h) do { _Pragma("unroll") for (int m = 0; m < 4; ++m) _Pragma("unroll") for (int k = 0; k < 2; ++k) dst[m][k] = *(const PG8_LAS bf16x8*)(lds + PG8_SA(b, h) + aoff + m * 2048 + k * 1024); } while (0)
#define PG8_LDB(dst, b, h) do { _Pragma("unroll") for (int n = 0; n < 2; ++n) _Pragma("unroll") for (int k = 0; k < 2; ++k) dst[n][k] = *(const PG8_LAS bf16x8*)(lds + PG8_SB(b, h) + boff + n * 2048 + k * 1024); } while (0)
#define PG8_MMA(ai, bj, At, Bt) do { __builtin_amdgcn_s_setprio(1); _Pragma("unroll") for (int m = 0; m < 4; ++m) _Pragma("unroll") for (int n = 0; n < 2; ++n) _Pragma("unroll") for (int k = 0; k < 2; ++k) \
        acc[ai][bj][m][n] = __builtin_amdgcn_mfma_f32_16x16x32_bf16(Bt[n][k], At[m][k], acc[ai][bj][m][n], 0, 0, 0); __builtin_amdgcn_s_setprio(0); } while (0)
#define PG8_WAIT_V(n) asm volatile("s_waitcnt vmcnt(" #n ")" ::: "memory")
#define PG8_WAIT_L(n) asm volatile("s_waitcnt lgkmcnt(" #n ")" ::: "memory")
#define PG8_BAR __builtin_amdgcn_s_barrier()
#define PG8_SCHED __builtin_amdgcn_sched_barrier(0)
    Unit cur, nxt; int ui = 0;
    if (!S.next(0, cur)) return;
    f32x4 acc[2][2][4][2];
#pragma unroll
    for (int a = 0; a < 2; ++a)
#pragma unroll
        for (int b = 0; b < 2; ++b)
#pragma unroll
            for (int m = 0; m < 4; ++m)
#pragma unroll
                for (int n = 0; n < 2; ++n) acc[a][b][m][n] = (f32x4){0.f, 0.f, 0.f, 0.f};
    bf16x8 At[4][2], B0[2][2], B1[2][2];
    const char* cA = (const char*)g.A + (size_t)cur.pm * tstep; const char* cB = (const char*)g.Bt + (size_t)cur.pn * tstep;
    S.a_ready(cur);
    PG8_STAGE(PG8_SB(0, 0), cB, voffB); PG8_STAGE(PG8_SA(0, 0), cA, voffA); PG8_STAGE(PG8_SB(0, 1), cB + hstep, voffB); PG8_STAGE(PG8_SA(0, 1), cA + hstep, voffA);
    if (wr == 1) PG8_BAR;
    PG8_WAIT_V(4); PG8_BAR;
    PG8_STAGE(PG8_SB(1, 0), cB + kstep, voffB); PG8_STAGE(PG8_SA(1, 0), cA + kstep, voffA); PG8_STAGE(PG8_SB(1, 1), cB + hstep + kstep, voffB);
    PG8_WAIT_V(6); PG8_BAR;
    PG8_STAMP();
    for (;;) {
        const bool has_next = S.next(ui + 1, nxt);
        if constexpr (Epi::HAS_PRE) E.pre(cur, wr, wc, fr, fq);
        const char* nA = has_next ? (const char*)g.A + (size_t)nxt.pm * tstep : cA; const char* nB = has_next ? (const char*)g.Bt + (size_t)nxt.pn * tstep : cB;
        for (int t = 0; t < nt; t += 2) {
            const bool last = (t == nt - 2);
            const char* a1 = cA + (size_t)(t + 1) * kstep;
            const char* a2 = last ? nA : cA + (size_t)(t + 2) * kstep; const char* b2 = last ? nB : cB + (size_t)(t + 2) * kstep;
            const char* a3 = a2 + kstep; const char* b3 = b2 + kstep;
            if (last && has_next) S.a_ready(nxt);
            PG8_LDB(B0, 0, 0); PG8_SCHED; PG8_LDA(At, 0, 0); PG8_STAGE(PG8_SA(1, 1), a1 + hstep, voffA);
            PG8_WAIT_L(8); PG8_BAR; PG8_WAIT_L(0); PG8_MMA(0, 0, At, B0); PG8_BAR; PG8_SCHED;
            PG8_LDB(B1, 0, 1); PG8_STAGE(PG8_SB(0, 0), b2, voffB);
            PG8_BAR; PG8_WAIT_L(0); PG8_MMA(0, 1, At, B1); PG8_BAR;
            PG8_LDA(At, 0, 1); PG8_STAGE(PG8_SA(0, 0), a2, voffA);
            PG8_BAR; PG8_WAIT_L(0); PG8_MMA(1, 0, At, B0); PG8_BAR; PG8_SCHED;
            PG8_STAGE(PG8_SB(0, 1), b2 + hstep, voffB);
            PG8_WAIT_V(6); PG8_BAR; PG8_MMA(1, 1, At, B1); PG8_BAR;
            PG8_LDB(B0, 1, 0); PG8_SCHED; PG8_LDA(At, 1, 0); PG8_STAGE(PG8_SA(0, 1), a2 + hstep, voffA);
            PG8_WAIT_L(8); PG8_BAR; PG8_WAIT_L(0); PG8_MMA(0, 0, At, B0); PG8_BAR; PG8_SCHED;
            PG8_LDB(B1, 1, 1); PG8_STAGE(PG8_SB(1, 0), b3, voffB);
            PG8_BAR; PG8_WAIT_L(0); PG8_MMA(0, 1, At, B1); PG8_BAR;
            PG8_LDA(At, 1, 1); PG8_STAGE(PG8_SA(1, 0), a3, voffA);
            PG8_BAR; PG8_WAIT_L(0); PG8_MMA(1, 0, At, B0); PG8_BAR; PG8_SCHED;
            PG8_STAGE(PG8_SB(1, 1), b3 + hstep, voffB);
            PG8_WAIT_V(6); PG8_BAR; PG8_MMA(1, 1, At, B1); PG8_BAR;
        }
        PG8_STAMP();
        if constexpr (!Epi::AFTER_DRAIN) { E(acc, cur, wr, wc, fr, fq); S.done(cur); }
        PG8_STAMP();
        if (!has_next) break;
#pragma unroll
        for (int a = 0; a < 2; ++a)
#pragma unroll
            for (int b = 0; b < 2; ++b)
#pragma unroll
                for (int m = 0; m < 4; ++m)
#pragma unroll
                    for (int n = 0; n < 2; ++n) acc[a][b][m][n] = (f32x4){0.f, 0.f, 0.f, 0.f};
        cur = nxt; cA = nA; cB = nB; ++ui;
    }
    PG8_WAIT_V(0);
    if (wr == 0) PG8_BAR;
    PG8_BAR;
    if constexpr (Epi::AFTER_DRAIN) { E.fused(acc, cur, wr, wc, fr, fq, lds, wid, lane); S.done(cur); }
    PG8_STAMP();
    if (STAMP && wid == 0) { stamps[lane] = lane < nts ? (((unsigned long long)(unsigned)ts_hi << 32) | (unsigned)ts_lo) : 0ull;
        if (lane == 62) stamps[62] = rt_entry; if (lane == 63) stamps[63] = (unsigned long long)wall_clock64(); }
#undef PG8_STAMP
#undef PG8_SA
#undef PG8_SB
#undef PG8_STAGE
#undef PG8_LDA
#undef PG8_LDB
#undef PG8_MMA
#undef PG8_WAIT_V
#undef PG8_WAIT_L
#undef PG8_BAR
#undef PG8_SCHED
}
template <class Epi, class Sched, bool STAMP = false>
__device__ __forceinline__ void gemm_phase_ga(PG8_LAS unsigned char* lds, const Gemm g, const Sched& S, const Epi& E, unsigned long long* stamps) {
    const int tid = threadIdx.x, wid = __builtin_amdgcn_readfirstlane(tid >> 6), lane = tid & 63, wr = wid >> 2, wc = wid & 3, fr = lane & 15, fq = lane >> 4;
    const int K = g.K, nt = K / BK;
    int ts_lo = 0, ts_hi = 0, nts = 0; const unsigned long long rt_entry = STAMP ? (unsigned long long)wall_clock64() : 0ull;
#define PG8_STAMP() do { if (STAMP && wid == 0 && nts < 64) { const unsigned long long _c = (unsigned long long)clock64(); \
        ts_lo = (lane == nts) ? (int)(unsigned)_c : ts_lo; ts_hi = (lane == nts) ? (int)(unsigned)(_c >> 32) : ts_hi; ++nts; } } while (0)
    PG8_STAMP();
    unsigned voffB[2]; int RA_[2]; unsigned CA2_[2];
#pragma unroll
    for (int i = 0; i < 2; ++i) { int R, C; stage_rc(tid * 16 + i * 8192, R, C); const int Rb = Epi::PERM ? ((R & ~31) + perm32(R & 31)) : R;
        RA_[i] = R; CA2_[i] = (unsigned)C * 2u; voffB[i] = (unsigned)(Rb * K + C) * 2u; }
    const size_t kstep = (size_t)(BK * 2);
    const size_t hstep = (size_t)HALF * K * 2;
    const size_t tstep = 2 * hstep;
    const unsigned ldsw = (unsigned)wid * 1024u;
    const int aoff = lds_byte(wr * 64 + fr, fq * 8), boff = lds_byte(wc * 32 + fr, fq * 8);
#define PG8_SA(b, h) (((b) * 2 + (h)) * HTB)
#define PG8_SB(b, h) ((4 + (b) * 2 + (h)) * HTB)
#define PG8_STAGE(bufoff, gbase, voff) do { _Pragma("unroll") for (int _i = 0; _i < 2; ++_i) \
        __builtin_amdgcn_global_load_lds((const unsigned*)((const char*)(gbase) + (voff)[_i]), (PG8_LAS unsigned*)(lds + (bufoff) + ldsw + _i * 8192), 16, 0, 0); } while (0)
#define PG8_LDA(dst, b, h) do { _Pragma("unroll") for (int m = 0; m < 4; ++m) _Pragma("unroll") for (int k = 0; k < 2; ++k) dst[m][k] = *(const PG8_LAS bf16x8*)(lds + PG8_SA(b, h) + aoff + m * 2048 + k * 1024); } while (0)
#define PG8_LDB(dst, b, h) do { _Pragma("unroll") for (int n = 0; n < 2; ++n) _Pragma("unroll") for (int k = 0; k < 2; ++k) dst[n][k] = *(const PG8_LAS bf16x8*)(lds + PG8_SB(b, h) + boff + n * 2048 + k * 1024); } while (0)
#define PG8_MMA(ai, bj, At, Bt) do { __builtin_amdgcn_s_setprio(1); _Pragma("unroll") for (int m = 0; m < 4; ++m) _Pragma("unroll") for (int n = 0; n < 2; ++n) _Pragma("unroll") for (int k = 0; k < 2; ++k) \
        acc[ai][bj][m][n] = __builtin_amdgcn_mfma_f32_16x16x32_bf16(Bt[n][k], At[m][k], acc[ai][bj][m][n], 0, 0, 0); __builtin_amdgcn_s_setprio(0); } while (0)
#define PG8_WAIT_V(n) asm volatile("s_waitcnt vmcnt(" #n ")" ::: "memory")
#define PG8_WAIT_L(n) asm volatile("s_waitcnt lgkmcnt(" #n ")" ::: "memory")
#define PG8_BAR __builtin_amdgcn_s_barrier()
#define PG8_SCHED __builtin_amdgcn_sched_barrier(0)
    Unit cur, nxt; int ui = 0;
    if (!S.next(0, cur)) return;
    f32x4 acc[2][2][4][2];
#pragma unroll
    for (int a = 0; a < 2; ++a)
#pragma unroll
        for (int b = 0; b < 2; ++b)
#pragma unroll
            for (int m = 0; m < 4; ++m)
#pragma unroll
                for (int n = 0; n < 2; ++n) acc[a][b][m][n] = (f32x4){0.f, 0.f, 0.f, 0.f};
    bf16x8 At[4][2], B0[2][2], B1[2][2];
    const char* gA = (const char*)g.A; const char* cB = (const char*)g.Bt + (size_t)cur.pn * tstep;
    unsigned curA[2][2], nxtA[2][2];
#define PG8_GA_ROWS(dst, u_) do { _Pragma("unroll") for (int i_ = 0; i_ < 2; ++i_) { unsigned o_[2]; S.rows(u_, RA_[i_], o_); dst[0][i_] = o_[0] + CA2_[i_]; dst[1][i_] = o_[1] + CA2_[i_]; } } while (0)
    PG8_GA_ROWS(curA, cur);
    S.a_ready(cur);
    PG8_STAGE(PG8_SB(0, 0), cB, voffB); PG8_STAGE(PG8_SA(0, 0), gA, curA[0]); PG8_STAGE(PG8_SB(0, 1), cB + hstep, voffB); PG8_STAGE(PG8_SA(0, 1), gA, curA[1]);
    if (wr == 1) PG8_BAR;
    PG8_WAIT_V(4); PG8_BAR;
    PG8_STAGE(PG8_SB(1, 0), cB + kstep, voffB); PG8_STAGE(PG8_SA(1, 0), gA + kstep, curA[0]); PG8_STAGE(PG8_SB(1, 1), cB + hstep + kstep, voffB);
    PG8_WAIT_V(6); PG8_BAR;
    PG8_STAMP();
    for (;;) {
        const bool has_next = S.next(ui + 1, nxt);
        if constexpr (Epi::HAS_PRE) E.pre(cur, wr, wc, fr, fq);
        const char* nB = has_next ? (const char*)g.Bt + (size_t)nxt.pn * tstep : cB;
        if (has_next) PG8_GA_ROWS(nxtA, nxt); else { nxtA[0][0] = curA[0][0]; nxtA[0][1] = curA[0][1]; nxtA[1][0] = curA[1][0]; nxtA[1][1] = curA[1][1]; }
        for (int t = 0; t < nt; t += 2) {
            const bool last = (t == nt - 2);
            const char* a1 = gA + (size_t)(t + 1) * kstep;
            const char* a2 = last ? gA : gA + (size_t)(t + 2) * kstep; const char* b2 = last ? nB : cB + (size_t)(t + 2) * kstep;
            const unsigned s0_[2] = {last ? nxtA[0][0] : curA[0][0], last ? nxtA[0][1] : curA[0][1]}, s1_[2] = {last ? nxtA[1][0] : curA[1][0], last ? nxtA[1][1] : curA[1][1]};
            const char* a3 = a2 + kstep; const char* b3 = b2 + kstep;
            if (last && has_next) S.a_ready(nxt);
            PG8_LDB(B0, 0, 0); PG8_SCHED; PG8_LDA(At, 0, 0); PG8_STAGE(PG8_SA(1, 1), a1, curA[1]);
            PG8_WAIT_L(8); PG8_BAR; PG8_WAIT_L(0); PG8_MMA(0, 0, At, B0); PG8_BAR; PG8_SCHED;
            PG8_LDB(B1, 0, 1); PG8_STAGE(PG8_SB(0, 0), b2, voffB);
            PG8_BAR; PG8_WAIT_L(0); PG8_MMA(0, 1, At, B1); PG8_BAR;
            PG8_LDA(At, 0, 1); PG8_STAGE(PG8_SA(0, 0), a2, s0_);
            PG8_BAR; PG8_WAIT_L(0); PG8_MMA(1, 0, At, B0); PG8_BAR; PG8_SCHED;
            PG8_STAGE(PG8_SB(0, 1), b2 + hstep, voffB);
            PG8_WAIT_V(6); PG8_BAR; PG8_MMA(1, 1, At, B1); PG8_BAR;
            PG8_LDB(B0, 1, 0); PG8_SCHED; PG8_LDA(At, 1, 0); PG8_STAGE(PG8_SA(0, 1), a2, s1_);
            PG8_WAIT_L(8); PG8_BAR; PG8_WAIT_L(0); PG8_MMA(0, 0, At, B0); PG8_BAR; PG8_SCHED;
            PG8_LDB(B1, 1, 1); PG8_STAGE(PG8_SB(1, 0), b3, voffB);
            PG8_BAR; PG8_WAIT_L(0); PG8_MMA(0, 1, At, B1); PG8_BAR;
            PG8_LDA(At, 1, 1); PG8_STAGE(PG8_SA(1, 0), a3, s0_);
            PG8_BAR; PG8_WAIT_L(0); PG8_MMA(1, 0, At, B0); PG8_BAR; PG8_SCHED;
            PG8_STAGE(PG8_SB(1, 1), b3 + hstep, voffB);
            PG8_WAIT_V(6); PG8_BAR; PG8_MMA(1, 1, At, B1); PG8_BAR;
        }
        PG8_STAMP();
        if constexpr (!Epi::AFTER_DRAIN) { E(acc, cur, wr, wc, fr, fq); S.done(cur); }
        PG8_STAMP();
        if (!has_next) break;
#pragma unroll
        for (int a = 0; a < 2; ++a)
#pragma unroll
            for (int b = 0; b < 2; ++b)
#pragma unroll
                for (int m = 0; m < 4; ++m)
#pragma unroll
                    for (int n = 0; n < 2; ++n) acc[a][b][m][n] = (f32x4){0.f, 0.f, 0.f, 0.f};
        cur = nxt; cB = nB; ++ui; curA[0][0] = nxtA[0][0]; curA[0][1] = nxtA[0][1]; curA[1][0] = nxtA[1][0]; curA[1][1] = nxtA[1][1];
    }
    PG8_WAIT_V(0);
    if (wr == 0) PG8_BAR;
    PG8_BAR;
    if constexpr (Epi::AFTER_DRAIN) { E.fused(acc, cur, wr, wc, fr, fq, lds, wid, lane); S.done(cur); }
    PG8_STAMP();
    if (STAMP && wid == 0) { stamps[lane] = lane < nts ? (((unsigned long long)(unsigned)ts_hi << 32) | (unsigned)ts_lo) : 0ull;
        if (lane == 62) stamps[62] = rt_entry; if (lane == 63) stamps[63] = (unsigned long long)wall_clock64(); }
#undef PG8_STAMP
#undef PG8_GA_ROWS
#undef PG8_SA
#undef PG8_SB
#undef PG8_STAGE
#undef PG8_LDA
#undef PG8_LDB
#undef PG8_MMA
#undef PG8_WAIT_V
#undef PG8_WAIT_L
#undef PG8_BAR
#undef PG8_SCHED
}
}
#define XB_TMO      128
#define XB_XCNT(j)  (256  + 64 * (j))
#define XB_XSUB(j)  (1280 + 64 * (j))
#define XB_XGEN(j)  (2304 + 64 * (j))
#define XB_TOP      3328
#define XB_TOPGEN   3392
#define XCD_BAR_WORDS 3456
#define XB_SPIN_CAP (1u << 18)
#define LAS __attribute__((address_space(3)))

__device__ __forceinline__ unsigned xb_ld(unsigned* p)              { return __hip_atomic_load(p, __ATOMIC_RELAXED, __HIP_MEMORY_SCOPE_AGENT); }
__device__ __forceinline__ unsigned xb_add(unsigned* p, unsigned v) { return __hip_atomic_fetch_add(p, v, __ATOMIC_RELAXED, __HIP_MEMORY_SCOPE_AGENT); }
__device__ __forceinline__ unsigned xb_xcc_id() { return (unsigned)__builtin_amdgcn_s_getreg((3 << 11) | 20) & 0xFu; }
#define XB_SPIN(cond, bar) do { unsigned _sp = 0; while (cond) { __builtin_amdgcn_s_sleep(1); \
    if ((++_sp & 255u) == 0u) { if (xb_ld(&(bar)[XB_TMO])) break; if (_sp > XB_SPIN_CAP) { atomicAdd(&(bar)[XB_TMO], 1u); break; } } } } while (0)

struct XcdBarrier {
    unsigned* bar; unsigned x;
    volatile LAS unsigned* st;
};

__device__ __forceinline__ XcdBarrier xcd_barrier_post(unsigned* bar, volatile LAS unsigned* st) {
    XcdBarrier b; b.bar = bar; b.x = xb_xcc_id(); b.st = st;
    if (threadIdx.x == 0) (void)xb_add(&bar[XB_XCNT(b.x)], 1u);
    return b;
}
__device__ __forceinline__ void xcd_barrier_complete(unsigned* bar, unsigned x, unsigned& nloc, unsigned& nx) {
    const unsigned G = gridDim.x * gridDim.y * gridDim.z;
    unsigned sum, cnt, mine, sp = 0u;
    for (;;) {
        sum = 0u; cnt = 0u; mine = 0u;
#pragma unroll
        for (unsigned j = 0; j < 16; ++j) { const unsigned c = xb_ld(&bar[XB_XCNT(j)]); sum += c; cnt += (c > 0u) ? 1u : 0u; mine = (j == x) ? c : mine; }
        if (sum == G) break;
        __builtin_amdgcn_s_sleep(1);
        if ((++sp & 255u) == 0u) { if (xb_ld(&bar[XB_TMO])) break; if (sp > XB_SPIN_CAP) { atomicAdd(&bar[XB_TMO], 1u); break; } }
    }
    nloc = mine > 0u ? mine : 1u; nx = cnt > 0u ? cnt : 1u;
}

__device__ __forceinline__ void xcd_barrier(const XcdBarrier& b) {
    asm volatile("s_waitcnt vmcnt(0)" ::: "memory");
    __syncthreads();
    if (threadIdx.x == 0) {
        unsigned* bar = b.bar;
        __builtin_amdgcn_s_waitcnt(0);
        unsigned nloc = b.st[0], nx = b.st[1];
        if (nloc == 0u) { xcd_barrier_complete(bar, b.x, nloc, nx); b.st[0] = nloc; b.st[1] = nx; }
        const unsigned old = xb_add(&bar[XB_XSUB(b.x)], 1u);
        const unsigned gen = old / nloc;
        if (old + 1u == (gen + 1u) * nloc) {
            __builtin_amdgcn_fence(__ATOMIC_RELEASE, "agent");
            asm volatile("s_waitcnt vmcnt(0)" ::: "memory");
            const unsigned og = xb_add(&bar[XB_TOP], 1u);
            const unsigned tg = og / nx;
            if (og + 1u == (tg + 1u) * nx) xb_add(&bar[XB_TOPGEN], 1u);
            else XB_SPIN(xb_ld(&bar[XB_TOPGEN]) == tg, bar);
            __builtin_amdgcn_fence(__ATOMIC_ACQUIRE, "agent");
            xb_add(&bar[XB_XGEN(b.x)], 1u);
            asm volatile("s_waitcnt vmcnt(0)" ::: "memory");
        } else {
            XB_SPIN(xb_ld(&bar[XB_XGEN(b.x)]) == gen, bar);
            __builtin_amdgcn_fence(__ATOMIC_ACQUIRE, "agent");
            asm volatile("s_waitcnt vmcnt(0)" ::: "memory");
        }
    }
    __syncthreads();
}

typedef unsigned short bf16_t;
typedef float f32x4 __attribute__((ext_vector_type(4)));
typedef float f32x2v __attribute__((ext_vector_type(2)));
typedef unsigned u32x4 __attribute__((ext_vector_type(4)));
typedef unsigned u32x2 __attribute__((ext_vector_type(2)));

constexpr int D = 1024, NB = 2, SEQ = 16384, NCTX = 256;
constexpr int NL = NB * SEQ;
constexpr int NCT = NB * NCTX;
constexpr int TALL = NL + NCT;
constexpr int NH = 8, DK = 128;
constexpr int QKVC = 3072, GIN = 4128, GINP = 4352;
constexpr int NE = 32, DFF = 1024;
constexpr int MAXROWS = NL * 4 + NE * 256;
constexpr int NTHR = 512;
constexpr int LDS_BYTES = 160 * 1024;
constexpr int LDS_MISC = 128 * 1024;

constexpr size_t AL(size_t x) { return (x + 255) & ~(size_t)255; }
constexpr size_t WS_CTL   = 0;                               constexpr size_t CTL_BYTES = 65536;
constexpr size_t CTL_CNT  = 16384;
constexpr size_t CTL_SCANQ = 20480;
constexpr size_t CTL_PREPQ = 24576;
constexpr size_t CTL_CVTQ  = 28672;
constexpr size_t WS_MOD   = WS_CTL + CTL_BYTES;
constexpr size_t WS_POSR  = AL(WS_MOD + 2 * 3 * 6144 * 4);
constexpr size_t WS_POSC  = AL(WS_POSR + 256 * 512 * 4);
constexpr size_t WS_TILEE = AL(WS_POSC + 64 * 512 * 4);
constexpr size_t WS_FT    = AL(WS_TILEE + 2 * 1024 * 4);
constexpr size_t WS_TW    = AL(WS_FT + 65536);
constexpr size_t WS_WRT   = AL(WS_TW + 131072);
constexpr size_t WS_BTIN  = AL(WS_WRT + 262144);
constexpr size_t WS_BTOUT = AL(WS_BTIN + (size_t)GINP * 1024 * 2);
constexpr size_t WS_BTFN  = AL(WS_BTOUT + (size_t)1024 * 1024 * 2);
constexpr size_t WS_BTGU  = AL(WS_BTFN + (size_t)1024 * 2048 * 2);
constexpr size_t WS_BTDN  = AL(WS_BTGU + (size_t)2 * 32 * 2048 * 1024 * 2);
constexpr size_t WS_X0    = AL(WS_BTDN + (size_t)2 * 32 * 1024 * 1024 * 2);
constexpr size_t WS_HB    = AL(WS_X0 + (size_t)NL * 1024 * 4);
constexpr size_t WS_TOPE  = AL(WS_HB + (size_t)TALL * 1024 * 2);
constexpr size_t WS_TOPW  = AL(WS_TOPE + (size_t)NL * 16);
constexpr size_t WS_SLOT  = AL(WS_TOPW + (size_t)NL * 16);
constexpr size_t WS_POS   = AL(WS_SLOT + (size_t)NL * 16);
constexpr size_t WS_ROWTOK = AL(WS_POS + (size_t)NL * 16);
constexpr size_t WS_SCR   = AL(WS_ROWTOK + (size_t)NE * NL * 4);
constexpr size_t WS_PROJ  = WS_SCR;
constexpr size_t WS_GATES = AL(WS_PROJ + (size_t)TALL * 4096 * 2);
constexpr size_t SCN_BLK  = 98304;
constexpr size_t WS_SCN   = AL(WS_GATES + (size_t)TALL * 32 * 4);
constexpr size_t WS_DEC   = AL(WS_SCN + (size_t)8320 * SCN_BLK);
constexpr size_t WS_ODUMP = AL(WS_DEC + 8320 * 4);
constexpr size_t WS_SSAVE = AL(WS_ODUMP + 4096);
constexpr size_t WS_OF    = AL(WS_SSAVE + (size_t)64 * 8 * 64 * 32 * 4);
constexpr size_t WS_OB    = AL(WS_OF + (size_t)NL * 1024 * 2);
constexpr size_t WS_QKVC  = AL(WS_OB + (size_t)NL * 1024 * 2);
constexpr size_t WS_GDN_END = AL(WS_QKVC + (size_t)16 * 260 * 3 * 8192 * 2);
constexpr size_t WS_XS    = WS_SCR;
constexpr size_t WS_ACT   = AL(WS_XS + (size_t)MAXROWS * 1024 * 2);
constexpr size_t WS_MOE_END = AL(WS_ACT + (size_t)MAXROWS * 1024 * 2);
constexpr size_t WS_YR    = WS_SCR;
constexpr size_t WS_YI    = AL(WS_YR + (size_t)NL * 1024 * 2);
constexpr size_t WS_XCAT  = AL(WS_YI + (size_t)NL * 1024 * 2);
constexpr size_t WS_FN_END = AL(WS_XCAT + (size_t)NL * 2048 * 2);
constexpr size_t WS_END = WS_GDN_END > WS_MOE_END ? (WS_GDN_END > WS_FN_END ? WS_GDN_END : WS_FN_END) : (WS_MOE_END > WS_FN_END ? WS_MOE_END : WS_FN_END);

struct Args {
    const float* x; const float* c; const float* ctx; const float* c_ctx; const float* w_ada; const float* b_ada; const float* g_mix; const float* g_ffn;
    const float* gdn_w_in; const float* gdn_conv; const float* gdn_a_log; const float* gdn_dt_bias; const float* gdn_onorm; const float* gdn_w_out; const float* fnet_w_out;
    const float* moe_w_router; const float* moe_b_router; const float* moe_w_gu; const float* moe_b_gu; const float* moe_w_down; const float* moe_b_down; const float* g_final;
    float* out; unsigned char* ws; int ph_lo, ph_hi;
};

__device__ __forceinline__ unsigned short f2bf(float f) { unsigned u = __float_as_uint(f); u += 0x7fffu + ((u >> 16) & 1u); return (unsigned short)(u >> 16); }
__device__ __forceinline__ float bf2f(unsigned short h) { return __uint_as_float((unsigned)h << 16); }
__device__ __forceinline__ unsigned pack2(float a, float b) { return (unsigned)f2bf(a) | ((unsigned)f2bf(b) << 16); }
__device__ __forceinline__ float bflo(unsigned w) { return __uint_as_float(w << 16); }
__device__ __forceinline__ float bfhi(unsigned w) { return __uint_as_float(w & 0xffff0000u); }
__device__ __forceinline__ float wave_sum(float v) {
#pragma unroll
    for (int o = 32; o >= 1; o >>= 1) v += __shfl_xor(v, o);
    return v;
}
__device__ __forceinline__ float silu_f(float x) { return x * __builtin_amdgcn_rcpf(1.f + __expf(-x)); }
__device__ __forceinline__ float sigmoid_f(float x) { return 1.f / (1.f + __expf(-x)); }

struct EpiProj {
    static constexpr bool PERM = true, AFTER_DRAIN = false, HAS_PRE = false;
    bf16_t* P; float* Gt;
    __device__ __forceinline__ void operator()(const f32x4 (&acc)[2][2][4][2], const pg8::Unit& u, int wr, int wc, int fr, int fq) const {
        const int row0 = u.pm * 256 + wr * 64 + fr;
        if (u.pn < 16) {
            const int col0 = u.pn * 256 + wc * 32 + 8 * fq;
#pragma unroll
            for (int ai = 0; ai < 2; ++ai)
#pragma unroll
                for (int m = 0; m < 4; ++m) { bf16_t* rowp = P + (size_t)(row0 + ai * 128 + m * 16) * 4096 + col0;
#pragma unroll
                    for (int bj = 0; bj < 2; ++bj) { const f32x4 v0 = acc[ai][bj][m][0], v1 = acc[ai][bj][m][1];
                        u32x4 w; w.x = pg8::cvt_pk_bf16(v0[0], v0[1]); w.y = pg8::cvt_pk_bf16(v0[2], v0[3]); w.z = pg8::cvt_pk_bf16(v1[0], v1[1]); w.w = pg8::cvt_pk_bf16(v1[2], v1[3]);
                        *(u32x4*)(rowp + bj * 128) = w; } }
        } else if (wc == 0) {
#pragma unroll
            for (int ai = 0; ai < 2; ++ai)
#pragma unroll
                for (int m = 0; m < 4; ++m) { float* gp = Gt + (size_t)(row0 + ai * 128 + m * 16) * 32 + 8 * fq;
                    *(f32x4*)gp = acc[ai][0][m][0]; *(f32x4*)(gp + 4) = acc[ai][0][m][1]; }
        }
    }
};
struct EpiResid {
    static constexpr bool PERM = false, AFTER_DRAIN = false, HAS_PRE = false;
    float* X; const float* gate;
    __device__ __forceinline__ void operator()(const f32x4 (&acc)[2][2][4][2], const pg8::Unit& u, int wr, int wc, int fr, int fq) const {
        const int row0 = u.pm * 256 + wr * 64 + fr, col0 = u.pn * 256 + wc * 32 + 4 * fq;
        const float* gp = gate + (size_t)((u.pm * 256) >> 14) * 6144 + col0;
        f32x4 gv[2][2];
#pragma unroll
        for (int bj = 0; bj < 2; ++bj)
#pragma unroll
            for (int n = 0; n < 2; ++n) gv[bj][n] = *(const f32x4*)(gp + bj * 128 + n * 16);
#pragma unroll
        for (int ai = 0; ai < 2; ++ai)
#pragma unroll
            for (int m = 0; m < 4; ++m) { float* xp = X + (size_t)(row0 + ai * 128 + m * 16) * 1024 + col0; f32x4 xv[2][2];
#pragma unroll
                for (int bj = 0; bj < 2; ++bj)
#pragma unroll
                    for (int n = 0; n < 2; ++n) xv[bj][n] = *(const f32x4*)(xp + bj * 128 + n * 16);
                asm volatile("" ::: "memory");
#pragma unroll
                for (int bj = 0; bj < 2; ++bj)
#pragma unroll
                    for (int n = 0; n < 2; ++n) *(f32x4*)(xp + bj * 128 + n * 16) = xv[bj][n] + gv[bj][n] * acc[ai][bj][m][n]; }
    }
};
struct EpiResid0 {
    static constexpr bool PERM = false, AFTER_DRAIN = false, HAS_PRE = false;
    float* X; const float* xin; const float* posr; const float* posc; const float* gate;
    __device__ __forceinline__ void operator()(const f32x4 (&acc)[2][2][4][2], const pg8::Unit& u, int wr, int wc, int fr, int fq) const {
        const int row0 = u.pm * 256 + wr * 64 + fr, col0 = u.pn * 256 + wc * 32 + 4 * fq;
        const float* gp = gate + (size_t)((u.pm * 256) >> 14) * 6144 + col0;
        f32x4 gv[2][2];
#pragma unroll
        for (int bj = 0; bj < 2; ++bj)
#pragma unroll
            for (int n = 0; n < 2; ++n) gv[bj][n] = *(const f32x4*)(gp + bj * 128 + n * 16);
#pragma unroll
        for (int ai = 0; ai < 2; ++ai)
#pragma unroll
            for (int m = 0; m < 4; ++m) { const int r = row0 + ai * 128 + m * 16; const int tt = r & 16383; const size_t ro = (size_t)r * 1024 + col0;
                const float* pp = (col0 < 512) ? posr + (size_t)(tt >> 6) * 512 + col0 : posc + (size_t)(tt & 63) * 512 + (col0 - 512);
                f32x4 xv[2][2], pv[2][2];
#pragma unroll
                for (int bj = 0; bj < 2; ++bj)
#pragma unroll
                    for (int n = 0; n < 2; ++n) { xv[bj][n] = *(const f32x4*)(xin + ro + bj * 128 + n * 16); pv[bj][n] = *(const f32x4*)(pp + bj * 128 + n * 16); }
                asm volatile("" ::: "memory");
#pragma unroll
                for (int bj = 0; bj < 2; ++bj)
#pragma unroll
                    for (int n = 0; n < 2; ++n) *(f32x4*)(X + ro + bj * 128 + n * 16) = xv[bj][n] + pv[bj][n] + gv[bj][n] * acc[ai][bj][m][n]; }
    }
};
struct EpiGLU {
    static constexpr bool PERM = true, AFTER_DRAIN = false, HAS_PRE = true;
    bf16_t* ACT; const float* bgu;
    mutable f32x4 pb0, pb1, pb2, pb3;
    __device__ __forceinline__ void pre(const pg8::Unit& u, int wr, int wc, int fr, int fq) const { const float* bp = bgu + (size_t)(u.pn >> 3) * 2048 + 2 * ((u.pn & 7) * 128 + wc * 32 + 8 * fq);
        pb0 = *(const f32x4*)(bp); pb1 = *(const f32x4*)(bp + 4); pb2 = *(const f32x4*)(bp + 8); pb3 = *(const f32x4*)(bp + 12); }
    __device__ __forceinline__ void operator()(const f32x4 (&acc)[2][2][4][2], const pg8::Unit& u, int wr, int wc, int fr, int fq) const {
        const int e = u.pn >> 3, ct = u.pn & 7; const int row0 = u.pm * 256 + wr * 64 + fr; const int j0 = ct * 128 + wc * 32 + 8 * fq;
        const f32x4 b0 = pb0, b1 = pb1, b2 = pb2, b3 = pb3; (void)e;
        const float bg[8] = {b0[0], b0[2], b1[0], b1[2], b2[0], b2[2], b3[0], b3[2]}, bu[8] = {b0[1], b0[3], b1[1], b1[3], b2[1], b2[3], b3[1], b3[3]};
#pragma unroll
        for (int ai = 0; ai < 2; ++ai)
#pragma unroll
            for (int m = 0; m < 4; ++m) { float a[8];
#pragma unroll
                for (int n = 0; n < 2; ++n)
#pragma unroll
                    for (int i = 0; i < 4; ++i) { float gt = acc[ai][0][m][n][i] + bg[n * 4 + i], up = acc[ai][1][m][n][i] + bu[n * 4 + i];
                        gt = fminf(gt, 7.0f); up = fminf(fmaxf(up, -7.0f), 7.0f);
                        const float glu = gt * __builtin_amdgcn_rcpf(1.f + __expf(-1.702f * gt)); a[n * 4 + i] = (up + 1.f) * glu; }
                u32x4 w; w.x = pg8::cvt_pk_bf16(a[0], a[1]); w.y = pg8::cvt_pk_bf16(a[2], a[3]); w.z = pg8::cvt_pk_bf16(a[4], a[5]); w.w = pg8::cvt_pk_bf16(a[6], a[7]);
                *(u32x4*)(ACT + (size_t)(row0 + ai * 128 + m * 16) * 1024 + j0) = w; }
    }
};
struct EpiDown {
    static constexpr bool PERM = true, AFTER_DRAIN = false, HAS_PRE = true;
    bf16_t* YS; const float* bdn;
    mutable f32x4 pbv[2][2];
    __device__ __forceinline__ void pre(const pg8::Unit& u, int wr, int wc, int fr, int fq) const { const float* bp = bdn + (size_t)(u.pn >> 2) * 1024 + (u.pn & 3) * 256 + wc * 32 + 8 * fq;
#pragma unroll
        for (int bj = 0; bj < 2; ++bj)
#pragma unroll
            for (int n = 0; n < 2; ++n) pbv[bj][n] = *(const f32x4*)(bp + bj * 128 + 4 * n); }
    __device__ __forceinline__ void operator()(const f32x4 (&acc)[2][2][4][2], const pg8::Unit& u, int wr, int wc, int fr, int fq) const {
        const int e = u.pn >> 2, ct = u.pn & 3; const int row0 = u.pm * 256 + wr * 64 + fr; const int col0 = ct * 256 + wc * 32 + 8 * fq;
        f32x4 bv[2][2]; (void)e;
#pragma unroll
        for (int bj = 0; bj < 2; ++bj)
#pragma unroll
            for (int n = 0; n < 2; ++n) bv[bj][n] = pbv[bj][n];
#pragma unroll
        for (int ai = 0; ai < 2; ++ai)
#pragma unroll
            for (int m = 0; m < 4; ++m) { bf16_t* rowp = YS + (size_t)(row0 + ai * 128 + m * 16) * 1024 + col0;
#pragma unroll
                for (int bj = 0; bj < 2; ++bj) { const f32x4 v0 = acc[ai][bj][m][0] + bv[bj][0], v1 = acc[ai][bj][m][1] + bv[bj][1];
                    u32x4 w; w.x = pg8::cvt_pk_bf16(v0[0], v0[1]); w.y = pg8::cvt_pk_bf16(v0[2], v0[3]); w.z = pg8::cvt_pk_bf16(v1[0], v1[1]); w.w = pg8::cvt_pk_bf16(v1[2], v1[3]);
                    *(u32x4*)(rowp + bj * 128) = w; } }
    }
};
constexpr int MT_OFF = 131072;
struct MoeTab { int rb[32]; int cn[32]; int tb[33]; int nt; int te[560]; int nb; int be[224]; int bt0[224]; int bn[224]; };
__device__ __forceinline__ void moe_build_tables(const int* CNT, unsigned char* lds) {
    MoeTab* T = (MoeTab*)(lds + MT_OFF); const int t = threadIdx.x;
    __syncthreads();
    if (t < 64) { const int e = t & 31; const int c = CNT[e]; const int nt = (c + 255) >> 8; int inc = nt;
#pragma unroll
        for (int o = 1; o < 32; o <<= 1) { const int v = __shfl_up(inc, o, 32); if (e >= o) inc += v; }
        if (t < 32) { T->rb[e] = (inc - nt) * 256; T->cn[e] = c; T->tb[e] = inc - nt; if (e == 31) { T->tb[32] = inc; T->nt = inc; T->nb = 0; } } }
    __syncthreads();
    for (int rt = t; rt < T->nt; rt += NTHR) { int e = 0;
#pragma unroll
        for (int q = 1; q < 32; ++q) e += (T->tb[q] <= rt) ? 1 : 0;
        T->te[rt] = e; }
    __syncthreads();
}
constexpr int RT_OFF = MT_OFF + 8192, RT_MAXU = 20;
template <class Sched> __device__ __forceinline__ void moe_build_rowtab(const Sched& S, const int* rowtok, unsigned char* lds) {
    const MoeTab* T = (const MoeTab*)(lds + MT_OFF); int* RT = (int*)(lds + RT_OFF); const int t = threadIdx.x;
    int rtv[RT_MAXU / 2]; bool rok[RT_MAXU / 2];
#pragma unroll
    for (int k = 0; k < RT_MAXU / 2; ++k) { const int i = (t >> 8) + 2 * k; pg8::Unit u; rok[k] = S.next(i, u); rtv[k] = 0;
        if (rok[k]) { const int e = u.pn / S.nN; const int r = (u.pm - T->tb[e]) * 256 + (t & 255); if (r < T->cn[e]) rtv[k] = rowtok[(size_t)e * NL + r]; } }
#pragma unroll
    for (int k = 0; k < RT_MAXU / 2; ++k) { const int i = (t >> 8) + 2 * k; if (rok[k]) RT[i * 256 + (t & 255)] = rtv[k]; }
    __syncthreads();
}
template <bool RTFAST, bool XPERM> struct MoeOrderT {
    int G, c, nN; const MoeTab* T; const int* rowtab; unsigned K2; mutable int cursor;
    __device__ __forceinline__ bool next(int i, pg8::Unit& u) const {
        const int cp = (XPERM && (G & 7) == 0) ? (c & 7) * (G >> 3) + (c >> 3) : c;
        const int L = i * G + cp; const int nt = T->nt; if (L >= nt * nN) return false;
        const int rt = RTFAST ? L % nt : L / nN, ct = RTFAST ? L / nt : L % nN;
        u.pm = rt; u.pn = T->te[rt] * nN + ct; return true;
    }
    __device__ __forceinline__ void rows(const pg8::Unit& u, int R, unsigned (&o)[2]) const {
        const int cp = (XPERM && (G & 7) == 0) ? (c & 7) * (G >> 3) + (c >> 3) : c; const int i = (u.pm * nN + (u.pn % nN) - cp) / G; const int* r_ = rowtab + i * 256;
        o[0] = (unsigned)r_[R] * K2; o[1] = (unsigned)r_[R + 128] * K2;
    }
    __device__ __forceinline__ void a_ready(const pg8::Unit&) const {}
    __device__ __forceinline__ void done(const pg8::Unit&) const {}
};
typedef MoeOrderT<false, true> MoeOrder; typedef MoeOrderT<false, true> MoeOrderR;

#define LDSF(off) ((float*)(lds + (off)))

template <class RM> __device__ __forceinline__ void cvt_tile(const float* __restrict__ src, int ldsrc, int nsrc, bf16_t* __restrict__ dst, int lddst, int k0, int n0, float* tile, RM rm) {
    const int t = threadIdx.x; const int nn = t & 127, kq = t >> 7; float vin[16];
#pragma unroll
    for (int i = 0; i < 16; ++i) { const int kk = kq + 4 * i; vin[i] = (n0 + nn < nsrc) ? __builtin_nontemporal_load(src + (size_t)(k0 + kk) * ldsrc + n0 + nn) : 0.f;     }
#pragma unroll
    for (int i = 0; i < 16; ++i) { const int kk = kq + 4 * i; tile[kk * 129 + nn] = vin[i]; }
    __syncthreads();
#pragma unroll
    for (int i = 0; i < 2; ++i) { const int item = t + 512 * i; const int g8 = item & 7, n2 = item >> 3;
        if (n0 + n2 < nsrc) { float v[8];
#pragma unroll
            for (int j = 0; j < 8; ++j) v[j] = tile[(8 * g8 + j) * 129 + n2];
            u32x4 w; w.x = pack2(v[0], v[1]); w.y = pack2(v[2], v[3]); w.z = pack2(v[4], v[5]); w.w = pack2(v[6], v[7]);
            *(u32x4*)(dst + (size_t)rm(n0 + n2) * lddst + k0 + 8 * g8) = w; } }
    __syncthreads();
}
struct RMId { __device__ __forceinline__ int operator()(int n) const { return n; } };
struct RMGu { __device__ __forceinline__ int operator()(int n) const { const int j = n >> 1; return (j >> 7) * 256 + (j & 127) + ((n & 1) << 7); } };

constexpr int MOE_CVT_UNITS = 64 * 256 + 64 * 128;
__device__ __forceinline__ void moe_cvt_unit(const Args& a, float* tile, int q) {
    unsigned char* ws = a.ws;
    if (q < 64 * 256) { const int le = q >> 8, tt = q & 255;
        cvt_tile(a.moe_w_gu + (size_t)le * 1024 * 2048, 2048, 2048, (bf16_t*)(ws + WS_BTGU) + (size_t)le * 2048 * 1024, 1024, (tt >> 4) * 64, (tt & 15) * 128, tile, RMGu());
    } else { const int q2 = q - 64 * 256; const int le = q2 >> 7, tt = q2 & 127;
        cvt_tile(a.moe_w_down + (size_t)le * 1024 * 1024, 1024, 1024, (bf16_t*)(ws + WS_BTDN) + (size_t)le * 1024 * 1024, 1024, (tt >> 3) * 64, (tt & 7) * 128, tile, RMId()); }
}

__device__ __forceinline__ void p0_prologue(const Args& a, unsigned char* lds) {
    unsigned char* ws = a.ws; const int t = threadIdx.x; const int G = gridDim.x;
    float* MOD = (float*)(ws + WS_MOD);
    constexpr int U_ADA = 2 * 192, U_POS = 448, U_WIN = 16 * 33, U_WINZ = 7, U_WOUT = 16 * 8, U_GU = 64 * 256, U_DN = 64 * 128, U_FN = 256;
    constexpr int O_POS = U_ADA, O_WIN = O_POS + U_POS, O_WINZ = O_WIN + U_WIN, O_WOUT = O_WINZ + U_WINZ, O_GU = O_WOUT + U_WOUT, O_DN = O_GU + U_GU, O_FN = O_DN + U_DN, U_ALL = O_FN + U_FN;
    float* tile = LDSF(0);
    for (int uu = blockIdx.x; uu < U_ALL - (O_FN - O_GU); uu += G) { const int u = uu >= O_GU ? uu + (O_FN - O_GU) : uu;
        if (u < O_POS) {
            const int l = u / 192, cb = u % 192; float* sv = LDSF(0);
            const int col = t & 31, kp = t >> 5; const float* wp = a.w_ada + (size_t)l * 1024 * 6144 + cb * 32 + col;
            float wv_[64]; float cv_[6];
#pragma unroll
            for (int j = 0; j < 64; ++j) wv_[j] = wp[(size_t)(kp + 16 * j) * 6144];
#pragma unroll
            for (int j = 0; j < 6; ++j) { const int i = t + 512 * j; const int v = i >> 10, k = i & 1023; cv_[j] = v < 2 ? a.c[v * 1024 + k] : a.c_ctx[k]; }
#pragma unroll
            for (int j = 0; j < 6; ++j) sv[t + 512 * j] = silu_f(cv_[j]);
            __syncthreads();
            float s0 = 0.f, s1 = 0.f, s2 = 0.f;
#pragma unroll
            for (int j = 0; j < 64; ++j) { const int k = kp + 16 * j; const float w = wv_[j]; s0 += sv[k] * w; s1 += sv[1024 + k] * w; s2 += sv[2048 + k] * w; }
            float* red = LDSF(16384);
            red[(0 * 16 + kp) * 32 + col] = s0; red[(1 * 16 + kp) * 32 + col] = s1; red[(2 * 16 + kp) * 32 + col] = s2;
            __syncthreads();
            if (t < 96) { const int v = t >> 5, cc = t & 31; float s = 0.f; for (int k = 0; k < 16; ++k) s += red[(v * 16 + k) * 32 + cc];
                MOD[((size_t)l * 3 + v) * 6144 + cb * 32 + cc] = s + a.b_ada[l * 6144 + cb * 32 + cc]; }
            __syncthreads();
        } else if (u < O_WIN) {
            const int r = u - O_POS;
            if (r < 320) { const int p = r < 256 ? r : r - 256; float* dstp = (float*)(ws + (r < 256 ? WS_POSR : WS_POSC)) + (size_t)p * 512;
                const int i = t & 255; const double om = pow(10000.0, -(double)i / 256.0); const double ang = (double)p * om;
                dstp[t] = (float)(t < 256 ? sin(ang) : cos(ang)); }
            else if (r < 384) { bf16_t* ft = (bf16_t*)(ws + WS_FT);
                { const int i = (r - 320) * 512 + t; const int j = i & 7, ln = (i >> 3) & 63, ks = (i >> 9) & 3, mtp = (i >> 11) & 7, trig = i >> 14; const int m_ = ln & 15, g_ = ln >> 4;
                    const int n1 = 32 * ks + (j < 4 ? 4 * g_ + j : 16 + 4 * g_ + (j - 4)), k1 = 16 * mtp + m_; const double ang = 6.283185307179586476925 * (double)((k1 * n1) & 127) / 128.0;
                    ft[i] = f2bf((float)(trig ? sin(ang) : cos(ang))); } }
            else if (r < 416) { float* tw = (float*)(ws + WS_TW);
                { const int i = (r - 384) * 512 + t; const int n2 = i >> 7, k1 = i & 127; const double ang = 6.283185307179586476925 * (double)(n2 * k1) / 16384.0; *(f32x2v*)(tw + 2 * i) = (f32x2v){(float)cos(ang), (float)sin(ang)}; } }
            else { const int l = (r - 416) >> 4, q = (r - 416) & 15; bf16_t* wt = (bf16_t*)(ws + WS_WRT) + (size_t)l * 2 * 32768; const float* wr = a.moe_w_router + (size_t)l * 1024 * 32;
                float w[4];
#pragma unroll
                for (int j = 0; j < 4; ++j) { const int i = q * 2048 + t + 512 * j; const int e = i >> 10, k = i & 1023; w[j] = wr[k * 32 + e]; }
#pragma unroll
                for (int j = 0; j < 4; ++j) { const int i = q * 2048 + t + 512 * j; const bf16_t hi = f2bf(w[j]); wt[i] = hi; wt[32768 + i] = f2bf(w[j] - bf2f(hi)); } }
        } else if (u < O_WINZ) {
            const int q = u - O_WIN; cvt_tile(a.gdn_w_in, GIN, GIN, (bf16_t*)(ws + WS_BTIN), 1024, (q / 33) * 64, (q % 33) * 128, tile, RMId());
        } else if (u < O_WOUT) {
            const int q = u - O_WINZ; u32x4* p = (u32x4*)((bf16_t*)(ws + WS_BTIN) + (size_t)(GIN + q * 32) * 1024);
            for (int i = t; i < 32 * 1024 / 8; i += NTHR) p[i] = (u32x4){0u, 0u, 0u, 0u};
        } else if (u < O_GU) {
            const int q = u - O_WOUT; cvt_tile(a.gdn_w_out, 1024, 1024, (bf16_t*)(ws + WS_BTOUT), 1024, (q / 8) * 64, (q % 8) * 128, tile, RMId());
        } else if (u < O_FN) {
        } else {
            const int q = u - O_FN; const int part = q >> 7, g = (q >> 5) & 3, c0 = (q & 31) * 4; const int kb = part * 1024 + g * 256;
            float* trg = LDSF(0); float* trt = LDSF(1024);
            if (t < 256) { const double ang = 6.283185307179586476925 * (double)t / 256.0; trg[t] = (float)(part ? sin(ang) : cos(ang)); }
            __syncthreads();
#pragma unroll
            for (int j = 0; j < 2; ++j) { const int i = t + 512 * j; const int l = i >> 2, k = i & 3; trt[i] = trg[(l * (c0 + k)) & 255]; }
            __syncthreads();
            f32x2v acc[2][2][2];
#pragma unroll
            for (int jj = 0; jj < 2; ++jj)
#pragma unroll
                for (int eo = 0; eo < 2; ++eo) { acc[jj][eo][0] = (f32x2v){0.f, 0.f}; acc[jj][eo][1] = (f32x2v){0.f, 0.f}; }
            const float* wf = a.fnet_w_out + (size_t)(g * 256) * 1024;
#pragma unroll 1
            for (int l0 = 0; l0 < 256; l0 += 32) { float w0[32], w1[32];
#pragma unroll
                for (int j = 0; j < 32; ++j) { w0[j] = *(const float*)((const char*)wf + (unsigned)(((l0 + j) * 1024 + t) * 4)); w1[j] = *(const float*)((const char*)wf + (unsigned)(((l0 + j) * 1024 + t + 512) * 4)); }
#pragma unroll
                for (int j = 0; j < 32; ++j) { if ((j & 7) == 0) asm volatile("" ::: "memory"); const f32x4 ta = *(const f32x4*)(trt + (l0 + j) * 4); const f32x2v tr2[2] = {{ta[0], ta[1]}, {ta[2], ta[3]}};
#pragma unroll
                    for (int k = 0; k < 2; ++k) { acc[0][j & 1][k] += tr2[k] * w0[j]; acc[1][j & 1][k] += tr2[k] * w1[j]; } } }
            bf16_t* bt = (bf16_t*)(ws + WS_BTFN);
#pragma unroll
            for (int jj = 0; jj < 2; ++jj) { const float s = 1.0f / 2048.0f; const f32x2v e0 = acc[jj][0][0], e1 = acc[jj][0][1], o0 = acc[jj][1][0], o1 = acc[jj][1][1];
                u32x2 lo, hi; lo.x = pack2((e0[0] + o0[0]) * s, (e0[1] + o0[1]) * s); lo.y = pack2((e1[0] + o1[0]) * s, (e1[1] + o1[1]) * s);
                hi.x = pack2((e0[0] - o0[0]) * s, (e0[1] - o0[1]) * s); hi.y = pack2((e1[0] - o1[0]) * s, (e1[1] - o1[1]) * s);
                bf16_t* rowp = bt + (size_t)(t + 512 * jj) * 2048 + kb + c0; *(u32x2*)rowp = lo; *(u32x2*)(rowp + 128) = hi; }
            __syncthreads();
        }
    }
}

__device__ __forceinline__ void p1_embed(const Args& a) {
    unsigned char* ws = a.ws; const int lane = threadIdx.x & 63, wv = threadIdx.x >> 6;
    const float* MOD = (const float*)(ws + WS_MOD); const float* POSR = (const float*)(ws + WS_POSR); const float* POSC = (const float*)(ws + WS_POSC);
    float* X0 = (float*)(ws + WS_X0); bf16_t* HB = (bf16_t*)(ws + WS_HB);
    f32x4 gm[4];
#pragma unroll
    for (int i = 0; i < 4; ++i) gm[i] = *(const f32x4*)(a.g_mix + i * 256 + lane * 4);
    for (int r = blockIdx.x * 8 + wv; r < TALL; r += gridDim.x * 8) {
        f32x4 xv[4], sh[4], sc[4]; const float* mv; float ss = 0.f;
        if (r < NCT) { const float* src = a.ctx + (size_t)r * 1024; mv = MOD + 2 * 6144;
#pragma unroll
            for (int i = 0; i < 4; ++i) xv[i] = __builtin_nontemporal_load((const f32x4*)(src + i * 256 + lane * 4));
        } else { const int n = r - NCT; const int b = n >> 14, tt = n & 16383; const float* src = a.x + (size_t)n * 1024; mv = MOD + b * 6144;
            const float* pr = POSR + (size_t)(tt >> 6) * 512; const float* pc = POSC + (size_t)(tt & 63) * 512;
#pragma unroll
            for (int i = 0; i < 4; ++i) { const int c = i * 256 + lane * 4; const f32x4 pv = c < 512 ? *(const f32x4*)(pr + c) : *(const f32x4*)(pc + c - 512); xv[i] = __builtin_nontemporal_load((const f32x4*)(src + c)) + pv; }
        }
#pragma unroll
        for (int i = 0; i < 4; ++i) { const int c = i * 256 + lane * 4; sh[i] = *(const f32x4*)(mv + c); sc[i] = *(const f32x4*)(mv + 1024 + c); }
#pragma unroll
        for (int i = 0; i < 4; ++i) ss += xv[i][0] * xv[i][0] + xv[i][1] * xv[i][1] + xv[i][2] * xv[i][2] + xv[i][3] * xv[i][3];
        ss = wave_sum(ss); const float rstd = rsqrtf(ss * (1.0f / 1024.0f) + 1e-6f);
#pragma unroll
        for (int i = 0; i < 4; ++i) { const int c = i * 256 + lane * 4;
            const f32x4 hv = xv[i] * rstd * gm[i] * (sc[i] + 1.0f) + sh[i]; u32x2 w; w.x = pack2(hv[0], hv[1]); w.y = pack2(hv[2], hv[3]); *(u32x2*)(HB + (size_t)r * 1024 + c) = w; }
    }
}

typedef short bf16x8 __attribute__((ext_vector_type(8)));
typedef unsigned long long u64_t;
#define MFMA16(A, B, C) __builtin_amdgcn_mfma_f32_16x16x32_bf16((A), (B), (C), 0, 0, 0)
__device__ __forceinline__ bf16x8 mk_frag(u64_t lo, u64_t hi) { union { u64_t q[2]; bf16x8 v; } x; x.q[0] = lo; x.q[1] = hi; return x.v; }
__device__ __forceinline__ u64_t pack4(const f32x4 v) { return (u64_t)pg8::cvt_pk_bf16(v[0], v[1]) | ((u64_t)pg8::cvt_pk_bf16(v[2], v[3]) << 32); }
__device__ __forceinline__ void raw_barrier() { asm volatile("s_waitcnt lgkmcnt(0)" ::: "memory"); __builtin_amdgcn_s_barrier(); asm volatile("" ::: "memory"); }

constexpr int PL_RAW = 0;
constexpr int PL_AN = 0;
constexpr int PL_ATT = 9216;
constexpr int PL_A32 = 18432;
constexpr int PL_TINV = 22592;
constexpr int PL_Q = 55488;
constexpr int PL_K = PL_Q + 17408;
constexpr int PL_V = PL_K + 17408;
constexpr int PL_KT = PL_V + 17408;
constexpr int PL_SC = PL_KT + 18432;
constexpr int PL_CW = PL_SC + 1024;
static_assert(PL_CW + 7680 <= LDS_BYTES - 16, "prep LDS");

__device__ __forceinline__ void chain_step_rows(int chain, int step, int& r0, int& lo, int& hi) {
    const int b = chain >> 4, dir = chain & 1;
    if (step < 4) { const int ci = dir ? 3 - step : step; lo = b * NCTX; hi = lo + NCTX; r0 = lo + 64 * ci; }
    else { const int ci = dir ? 255 - (step - 4) : step - 4; lo = NCT + b * SEQ; hi = lo + SEQ; r0 = lo + 64 * ci; }
}

template <int MODE>
__device__ __forceinline__ void prep_unit(const Args& a, unsigned char* lds, const int u, int& cwh) {
    unsigned char* ws = a.ws; const int t = threadIdx.x, lane = t & 63, wv = t >> 6; const int m = lane & 15, g = lane >> 4;
    const bf16_t* PROJ = (const bf16_t*)(ws + WS_PROJ); const float* GATES = (const float*)(ws + WS_GATES); float* DEC = (float*)(ws + WS_DEC);
    float* sc_beta = LDSF(PL_SC), * sc_gc = sc_beta + 64, * sc_egc = sc_beta + 128, * sc_ekd = sc_beta + 192; float* cw = LDSF(PL_CW);
    {
        const int step = u >> 5, chain = u & 31; const int h = (chain >> 1) & 7, dir = chain & 1; int r0, slo, shi; chain_step_rows(chain, step, r0, slo, shi);
        unsigned char* blk = ws + WS_SCN + (size_t)u * SCN_BLK;
        int tl = t; asm volatile("" : "+v"(tl));
        float gb = 0.f, ga = 0.f, dtb = 0.f, alg = 0.f;
        if (wv == 0) { const int row = r0 + (dir ? 63 - lane : lane); gb = GATES[(size_t)row * 32 + dir * 8 + h]; ga = GATES[(size_t)row * 32 + 16 + dir * 8 + h]; dtb = a.gdn_dt_bias[dir * 8 + h]; alg = a.gdn_a_log[dir * 8 + h]; }
        const int sc_ = dir ? (step < 4 ? 3 - step : 263 - step) : step; bf16_t* qc = (bf16_t*)(ws + WS_QKVC) + (size_t)(((chain >> 4) * 8 + h) * 260 + sc_) * 3 * 8192;
        u32x4 rv[MODE == 0 ? 7 : 6]; float cwv[4];
        if (MODE == 0) {
#pragma unroll
            for (int j = 0; j < 7; ++j) { const int p = tl + 512 * j; const int pq = p < 68 * 48 ? p : 68 * 48 - 1; const int rowl = pq / 48, rem = pq % 48; const int seg = rem >> 4, pc = rem & 15; const int row = r0 - 2 + rowl;
                const int rowc = row < slo ? slo : row >= shi ? shi - 1 : row; const u32x4 v = __builtin_nontemporal_load((const u32x4*)(PROJ + (size_t)rowc * 4096 + seg * 1024 + h * 128 + pc * 8));
                rv[j] = (row >= slo && row < shi) ? v : (u32x4){0u, 0u, 0u, 0u}; }
            if (cwh != h) {
#pragma unroll
                for (int j = 0; j < 4; ++j) { const int i = tl + 512 * j; const int iq = i < 1920 ? i : 1919; const int seg = iq / 640, rem = iq % 640; const int jj = rem >> 7, c = rem & 127; cwv[j] = a.gdn_conv[jj * 3072 + seg * 1024 + h * 128 + c]; } }
        } else {
#pragma unroll
            for (int j = 0; j < 6; ++j) { const int p = tl + 512 * j; const int seg = p >> 10, rowv = (p >> 4) & 63, pc = p & 15; const int ol = dir ? 63 - rowv : rowv; rv[j] = __builtin_nontemporal_load((const u32x4*)(qc + (seg * 64 + ol) * 128 + pc * 8)); }
        }
        asm volatile("" : "+v"(gb), "+v"(ga), "+v"(dtb), "+v"(alg));
        if (wv == 0) {
            const float xx = ga + dtb; const float sp = xx > 20.f ? xx : log1pf(expf(xx));
            const float gv = -expf(alg) * sp; float gc = gv;
#pragma unroll
            for (int o = 1; o < 64; o <<= 1) { const float v = __shfl_up(gc, o); if (lane >= o) gc += v; }
            const float gl = __shfl(gc, 63);
            sc_beta[lane] = 1.f / (1.f + expf(-gb)); sc_gc[lane] = gc; sc_egc[lane] = expf(gc); sc_ekd[lane] = expf(gl - gc);
            if (lane == 0) DEC[chain * 260 + step] = expf(gl); }
        if (MODE == 0) {
            if (cwh != h) {
#pragma unroll
                for (int j = 0; j < 4; ++j) { const int i = tl + 512 * j; if (i < 1920) cw[i] = cwv[j]; }
                cwh = h; }
#pragma unroll
            for (int j = 0; j < 7; ++j) { const int p = tl + 512 * j; const int rowl = p / 48, rem = p % 48; const int seg = rem >> 4, pc = rem & 15;
                if (p < 68 * 48) *(u32x4*)(lds + PL_RAW + ((seg * 68 + rowl) * 136 + pc * 8) * 2) = rv[j]; }
        } else {
#pragma unroll
            for (int j = 0; j < 6; ++j) { const int p = tl + 512 * j; const int seg = p >> 10, rowv = (p >> 4) & 63, pc = p & 15;
                *(u32x4*)(lds + (seg == 0 ? PL_Q : seg == 1 ? PL_K : PL_V) + (rowv * 136 + pc * 8) * 2) = rv[j]; }
        }
        raw_barrier();
        if (MODE == 1) { const int rowv = t >> 3, p = t & 7; const unsigned char* kp = lds + PL_K + (rowv * 136 + 16 * p) * 2; const u32x4 k0 = *(const u32x4*)kp, k1 = *(const u32x4*)(kp + 16);
            const float ek = sc_ekd[rowv]; bf16_t* kt = (bf16_t*)(lds + PL_KT); const unsigned kw[8] = {k0.x, k0.y, k0.z, k0.w, k1.x, k1.y, k1.z, k1.w};
#pragma unroll
            for (int c = 0; c < 8; ++c) { kt[(16 * p + 2 * c) * 72 + rowv] = f2bf(bflo(kw[c]) * ek); kt[(16 * p + 2 * c + 1) * 72 + rowv] = f2bf(bfhi(kw[c]) * ek); }
        } else
        { const int ol = t >> 3, p = t & 7; const int vi = dir ? 63 - ol : ol;
#pragma unroll 1
          for (int seg = 0; seg < 3; ++seg) { float acc[16];
#pragma unroll
              for (int c = 0; c < 16; ++c) acc[c] = 0.f;
#pragma unroll
              for (int j = 0; j < 5; ++j) { const unsigned char* rp = lds + PL_RAW + ((seg * 68 + ol + j) * 136 + 16 * p) * 2; const u32x4 x0 = *(const u32x4*)rp, x1 = *(const u32x4*)(rp + 16);
                  const float* wp = cw + (seg * 5 + j) * 128 + 16 * p; const f32x4 w0 = *(const f32x4*)wp, w1 = *(const f32x4*)(wp + 4), w2 = *(const f32x4*)(wp + 8), w3 = *(const f32x4*)(wp + 12);
                  acc[0] += bflo(x0.x) * w0[0]; acc[1] += bfhi(x0.x) * w0[1]; acc[2] += bflo(x0.y) * w0[2]; acc[3] += bfhi(x0.y) * w0[3];
                  acc[4] += bflo(x0.z) * w1[0]; acc[5] += bfhi(x0.z) * w1[1]; acc[6] += bflo(x0.w) * w1[2]; acc[7] += bfhi(x0.w) * w1[3];
                  acc[8] += bflo(x1.x) * w2[0]; acc[9] += bfhi(x1.x) * w2[1]; acc[10] += bflo(x1.y) * w2[2]; acc[11] += bfhi(x1.y) * w2[3];
                  acc[12] += bflo(x1.z) * w3[0]; acc[13] += bfhi(x1.z) * w3[1]; acc[14] += bflo(x1.w) * w3[2]; acc[15] += bfhi(x1.w) * w3[3]; }
              float ss = 0.f;
#pragma unroll
              for (int c = 0; c < 16; ++c) { acc[c] = silu_f(acc[c]); ss += acc[c] * acc[c]; }
              if (seg < 2) { ss += __shfl_xor(ss, 1); ss += __shfl_xor(ss, 2); ss += __shfl_xor(ss, 4); const float scl = rsqrtf(ss + 1e-6f) * (seg == 0 ? 0.08838834764831845f : 1.0f);
#pragma unroll
                  for (int c = 0; c < 16; ++c) acc[c] *= scl; }
              unsigned char* tp = lds + (seg == 0 ? PL_Q : seg == 1 ? PL_K : PL_V) + (vi * 136 + 16 * p) * 2;
              u32x4 o0, o1; o0.x = pack2(acc[0], acc[1]); o0.y = pack2(acc[2], acc[3]); o0.z = pack2(acc[4], acc[5]); o0.w = pack2(acc[6], acc[7]);
              o1.x = pack2(acc[8], acc[9]); o1.y = pack2(acc[10], acc[11]); o1.z = pack2(acc[12], acc[13]); o1.w = pack2(acc[14], acc[15]);
              *(u32x4*)tp = o0; *(u32x4*)(tp + 16) = o1;
              if (seg == 1) { const float ek = sc_ekd[vi]; bf16_t* kt = (bf16_t*)(lds + PL_KT);
#pragma unroll
                  for (int c = 0; c < 16; ++c) kt[(16 * p + c) * 72 + vi] = f2bf(acc[c] * ek); }
          } }
        raw_barrier();
        if (MODE == 0) {
#pragma unroll
            for (int j = 0; j < 6; ++j) { const int p = t + 512 * j; const int seg = p >> 10, rowv = (p >> 4) & 63, pc = p & 15; const int ol = dir ? 63 - rowv : rowv;
                *(u32x4*)(qc + (seg * 64 + ol) * 128 + pc * 8) = *(const u32x4*)(lds + (seg == 0 ? PL_Q : seg == 1 ? PL_K : PL_V) + (rowv * 136 + pc * 8) * 2); } }
        for (int idx = wv; idx < 20; idx += 8) { const int which = idx >= 10, lt = which ? idx - 10 : idx; const int ti = lt < 1 ? 0 : lt < 3 ? 1 : lt < 6 ? 2 : 3; const int tj = lt - ti * (ti + 1) / 2;
            const unsigned char* ap = lds + (which ? PL_Q : PL_K) + ((16 * ti + m) * 136 + 8 * g) * 2; const unsigned char* bp = lds + PL_K + ((16 * tj + m) * 136 + 8 * g) * 2;
            f32x4 acc = (f32x4){0.f, 0.f, 0.f, 0.f};
#pragma unroll
            for (int ks = 0; ks < 4; ++ks) acc = MFMA16(*(const bf16x8*)(ap + ks * 64), *(const bf16x8*)(bp + ks * 64), acc);
            const int j = 16 * tj + m; const float gj = sc_gc[j]; bf16_t* dst = (bf16_t*)(lds + (which ? PL_ATT : PL_AN));
#pragma unroll
            for (int e = 0; e < 4; ++e) { const int i = 16 * ti + 4 * g + e; const float dcy = __expf(fminf(sc_gc[i] - gj, 0.f));
                if (which) { dst[i * 72 + j] = f2bf(i >= j ? acc[e] * dcy : 0.f); }
                else { const float v = i > j ? sc_beta[i] * acc[e] * dcy : 0.f; dst[i * 72 + j] = f2bf(-v); if (ti == tj) LDSF(PL_A32)[ti * 260 + (4 * g + e) * 16 + m] = v; }
                if (ti != tj) dst[(16 * tj + 4 * g + e) * 72 + 16 * ti + m] = 0; }
        }
        raw_barrier();
        if (wv == 0) { const float* A = LDSF(PL_A32) + g * 260; float x[16];
            f32x4 Ar[16][4];
#pragma unroll
            for (int i = 1; i < 11; ++i)
#pragma unroll
                for (int q = 0; q < (i + 3) / 4; ++q) Ar[i][q] = *(const f32x4*)(A + i * 16 + 4 * q);
            __builtin_amdgcn_sched_barrier(0);
#pragma unroll
            for (int i = 0; i < 11; ++i) { float s = (i == m) ? 1.f : 0.f;
#pragma unroll
                for (int j = 0; j < i; ++j) s -= Ar[i][j >> 2][j & 3] * x[j];
                x[i] = s; }
            __builtin_amdgcn_sched_barrier(0);
#pragma unroll
            for (int i = 11; i < 16; ++i)
#pragma unroll
                for (int q = 0; q < (i + 3) / 4; ++q) Ar[i][q] = *(const f32x4*)(A + i * 16 + 4 * q);
            __builtin_amdgcn_sched_barrier(0);
#pragma unroll
            for (int i = 11; i < 16; ++i) { float s = (i == m) ? 1.f : 0.f;
#pragma unroll
                for (int j = 0; j < i; ++j) s -= Ar[i][j >> 2][j & 3] * x[j];
                x[i] = s; }
            bf16_t* ti_ = (bf16_t*)(lds + PL_TINV) + g * 16 * 24;
#pragma unroll
            for (int i = 0; i < 16; ++i) ti_[i * 24 + m] = f2bf(x[i]); }
        raw_barrier();
        const bool isK = wv >= 4; const int col0 = 32 * (wv & 3);
        u64_t XPq[2][2][2];
#pragma unroll
        for (int nt = 0; nt < 2; ++nt)
#pragma unroll
            for (int ks = 0; ks < 2; ++ks) { XPq[nt][ks][0] = 0ull; XPq[nt][ks][1] = 0ull; }
        { const bf16_t* src = (const bf16_t*)(lds + (isK ? PL_K : PL_V));
#pragma unroll
          for (int bi = 0; bi < 4; ++bi) { f32x4 acc[2];
#pragma unroll
              for (int nt = 0; nt < 2; ++nt)
#pragma unroll
                  for (int e = 0; e < 4; ++e) { const int i = 16 * bi + 4 * g + e; const float sc = sc_beta[i] * (isK ? sc_egc[i] : 1.f); acc[nt][e] = bf2f(src[i * 136 + col0 + 16 * nt + m]) * sc; }
              if (bi >= 1) {
#pragma unroll
                  for (int ks = 0; ks < 2; ++ks) { if (ks == 1 && bi < 3) continue;
                      const unsigned char* ap = lds + PL_AN + ((16 * bi + m) * 72 + 32 * ks + 4 * g) * 2; const bf16x8 af = mk_frag(*(const u64_t*)ap, *(const u64_t*)(ap + 32));
#pragma unroll
                      for (int nt = 0; nt < 2; ++nt) acc[nt] = MFMA16(af, mk_frag(XPq[nt][ks][0], XPq[nt][ks][1]), acc[nt]); } }
              const bf16x8 tf = mk_frag(*(const u64_t*)(lds + PL_TINV + ((bi * 16 + m) * 24 + 4 * g) * 2), 0ull);
#pragma unroll
              for (int nt = 0; nt < 2; ++nt) { const f32x4 xr = MFMA16(tf, mk_frag(pack4(acc[nt]), 0ull), ((f32x4){0.f, 0.f, 0.f, 0.f})); XPq[nt][bi >> 1][bi & 1] = pack4(xr); }
          } }
        if (!isK) {
#pragma unroll 1
            for (int mt = 0; mt < 8; ++mt) { bf16x8 kf[2];
#pragma unroll
                for (int ks = 0; ks < 2; ++ks) { const unsigned char* kp = lds + PL_KT + ((16 * mt + m) * 72 + 32 * ks + 4 * g) * 2; kf[ks] = mk_frag(*(const u64_t*)kp, *(const u64_t*)(kp + 32)); }
#pragma unroll
                for (int nt = 0; nt < 2; ++nt) { f32x4 acc = (f32x4){0.f, 0.f, 0.f, 0.f};
#pragma unroll
                    for (int ks = 0; ks < 2; ++ks) acc = MFMA16(kf[ks], mk_frag(XPq[nt][ks][0], XPq[nt][ks][1]), acc);
                    *(u64_t*)(blk + 49152 + (size_t)((((2 * wv + nt) * 4 + (mt >> 1)) * 64 + lane) * 16 + (mt & 1) * 8)) = pack4(acc); } }
#pragma unroll 1
            for (int mt = 0; mt < 4; ++mt) { bf16x8 af[2];
#pragma unroll
                for (int ks = 0; ks < 2; ++ks) { const unsigned char* ap = lds + PL_ATT + ((16 * mt + m) * 72 + 32 * ks + 4 * g) * 2; af[ks] = mk_frag(*(const u64_t*)ap, *(const u64_t*)(ap + 32)); }
#pragma unroll
                for (int nt = 0; nt < 2; ++nt) { f32x4 acc = (f32x4){0.f, 0.f, 0.f, 0.f};
#pragma unroll
                    for (int ks = 0; ks < 2; ++ks) acc = MFMA16(af[ks], mk_frag(XPq[nt][ks][0], XPq[nt][ks][1]), acc);
                    *(u64_t*)(blk + 81920 + (size_t)((((2 * wv + nt) * 2 + (mt >> 1)) * 64 + lane) * 16 + (mt & 1) * 8)) = pack4(acc); } }
        } else {
            const int ksp = wv - 4;
#pragma unroll 1
            for (int mt = 0; mt < 8; ++mt) { bf16x8 kf[2]; u64_t res[2];
#pragma unroll
                for (int ks = 0; ks < 2; ++ks) { const unsigned char* kp = lds + PL_KT + ((16 * mt + m) * 72 + 32 * ks + 4 * g) * 2; kf[ks] = mk_frag(*(const u64_t*)kp, *(const u64_t*)(kp + 32)); }
#pragma unroll
                for (int nt = 0; nt < 2; ++nt) { f32x4 acc = (f32x4){0.f, 0.f, 0.f, 0.f};
#pragma unroll
                    for (int ks = 0; ks < 2; ++ks) acc = MFMA16(mk_frag(XPq[nt][ks][0], XPq[nt][ks][1]), kf[ks], acc);
                    res[nt] = pack4(-acc); }
                u32x4 w; w.x = (unsigned)res[0]; w.y = (unsigned)(res[0] >> 32); w.z = (unsigned)res[1]; w.w = (unsigned)(res[1] >> 32);
                *(u32x4*)(blk + (size_t)(((mt * 4 + ksp) * 64 + lane) * 16)) = w; }
#pragma unroll 1
            for (int mt = 0; mt < 4; ++mt) { bf16x8 af[2]; u64_t res[2]; const float eg = sc_egc[16 * mt + m];
#pragma unroll
                for (int ks = 0; ks < 2; ++ks) { const unsigned char* ap = lds + PL_ATT + ((16 * mt + m) * 72 + 32 * ks + 4 * g) * 2; af[ks] = mk_frag(*(const u64_t*)ap, *(const u64_t*)(ap + 32)); }
#pragma unroll
                for (int nt = 0; nt < 2; ++nt) { f32x4 acc = (f32x4){0.f, 0.f, 0.f, 0.f};
#pragma unroll
                    for (int ks = 0; ks < 2; ++ks) acc = MFMA16(mk_frag(XPq[nt][ks][0], XPq[nt][ks][1]), af[ks], acc);
                    const u32x2 qw = *(const u32x2*)(lds + PL_Q + ((16 * mt + m) * 136 + 16 * (2 * ksp + nt) + 4 * g) * 2);
                    f32x4 r; r[0] = bflo(qw.x) * eg - acc[0]; r[1] = bfhi(qw.x) * eg - acc[1]; r[2] = bflo(qw.y) * eg - acc[2]; r[3] = bfhi(qw.y) * eg - acc[3];
                    res[nt] = pack4(r); }
                u32x4 w; w.x = (unsigned)res[0]; w.y = (unsigned)(res[0] >> 32); w.z = (unsigned)res[1]; w.w = (unsigned)(res[1] >> 32);
                *(u32x4*)(blk + 32768 + (size_t)(((mt * 4 + ksp) * 64 + lane) * 16)) = w; }
        }
        raw_barrier();
    }
}

constexpr int SCAN_SPLIT = 132;
static_assert(SCAN_SPLIT >= 132 && SCAN_SPLIT % 2 == 0, "P4's prep units take their q/k/v tiles from the cache written by P3's units of the opposite direction");
constexpr int CVT_SHARE0 = 0;
__device__ __forceinline__ void p3_prep(const Args& a, unsigned char* lds) {
    int cwh = -1;
    for (int u = blockIdx.x; u < SCAN_SPLIT * 32; u += gridDim.x) prep_unit<0>(a, lds, u, cwh);
}

__device__ __forceinline__ void scan_segment(const Args& a, unsigned char* lds, const int item, const int s0, const int s1, f32x4 (&S)[8]) {
    unsigned char* ws = a.ws; const int t = threadIdx.x, lane = t & 63, wv = t >> 6; const int m = lane & 15, g = lane >> 4;
    const float* DEC = (const float*)(ws + WS_DEC); float* decs = (float*)(lds + 147456 + 64);
    const int chain = item >> 1, half = item & 1; const int h = (chain >> 1) & 7, dir = chain & 1;
    const unsigned char* cb = ws + WS_SCN + (size_t)chain * SCN_BLK;
    {
        const int n = s1 - s0, n3 = ((n + 1) / 2) * 2;
        __syncthreads();
        {
            for (int i = t; i < n; i += NTHR) decs[i] = DEC[chain * 260 + s0 + i];
            __syncthreads();
            if (wv >= 4) {
                const int lt = t - 256; u32x4 RA[18], RB[18];
#define LD_STEP(R, k_) do { const int sc_ = s0 + ((k_) < n ? (k_) : n - 1); const unsigned char* sp_ = cb + (size_t)sc_ * (32 * SCN_BLK) + lt * 16; _Pragma("unroll") for (int j_ = 0; j_ < 18; ++j_) R[j_] = __builtin_nontemporal_load((const u32x4*)(sp_ + (j_ < 12 ? j_ * 4096 : j_ < 16 ? 49152 + half * 16384 + (j_ - 12) * 4096 : 81920 + half * 8192 + (j_ - 16) * 4096))); } while (0)
#define ST_SLOT(R, slot_) do { unsigned char* dp_ = lds + (slot_) * 73728 + lt * 16; _Pragma("unroll") for (int j_ = 0; j_ < 18; ++j_) *(u32x4*)(dp_ + j_ * 4096) = R[j_]; } while (0)
                LD_STEP(RA, 0); ST_SLOT(RA, 0); LD_STEP(RA, 1); LD_STEP(RB, 2);
                raw_barrier();
                for (int k = 0; k < n3; k += 2) {
                    ST_SLOT(RA, 1); LD_STEP(RA, k + 3);
                    raw_barrier();
                    ST_SLOT(RB, 0); LD_STEP(RB, k + 4);
                    raw_barrier();
                }
#undef LD_STEP
#undef ST_SLOT
            } else {
                const int slice = 4 * half + wv; bf16_t* O = (bf16_t*)(ws + (dir ? WS_OB : WS_OF));
                raw_barrier();
                for (int k = 0; k < n; ++k) { const int s = s0 + k;
                const unsigned char* slot = lds + (k & 1) * 73728 + lane * 16;
                u32x4 bc[4], oc[2];
#pragma unroll
                for (int q = 0; q < 4; ++q) bc[q] = *(const u32x4*)(slot + 49152 + (wv * 4 + q) * 1024);
#pragma unroll
                for (int q = 0; q < 2; ++q) oc[q] = *(const u32x4*)(slot + 65536 + (wv * 2 + q) * 1024);
                const float dec = decs[k];
                bf16x8 SB[4]; f32x4 aS[8], aO[4];
#pragma unroll
                for (int ks = 0; ks < 4; ++ks) SB[ks] = mk_frag(pack4(S[2 * ks]), pack4(S[2 * ks + 1]));
#pragma unroll
                for (int mt = 0; mt < 8; ++mt) { const unsigned w0 = (mt & 1) ? bc[mt >> 1].z : bc[mt >> 1].x, w1 = (mt & 1) ? bc[mt >> 1].w : bc[mt >> 1].y;
                    aS[mt][0] = S[mt][0] * dec + bflo(w0); aS[mt][1] = S[mt][1] * dec + bfhi(w0); aS[mt][2] = S[mt][2] * dec + bflo(w1); aS[mt][3] = S[mt][3] * dec + bfhi(w1); }
#pragma unroll
                for (int mt = 0; mt < 4; ++mt) { const unsigned w0 = (mt & 1) ? oc[mt >> 1].z : oc[mt >> 1].x, w1 = (mt & 1) ? oc[mt >> 1].w : oc[mt >> 1].y;
                    aO[mt][0] = bflo(w0); aO[mt][1] = bfhi(w0); aO[mt][2] = bflo(w1); aO[mt][3] = bfhi(w1); }
                bf16x8 FR[2][8];
#define FR_ADDR(f_) (slot + (((f_) % 12) < 8 ? ((((f_) % 12) * 4 + (f_) / 12) * 1024) : (32768 + ((((f_) % 12) - 8) * 4 + (f_) / 12) * 1024)))
#define LD_GRP(buf_, grp_) do { _Pragma("unroll") for (int q_ = 0; q_ < 8; ++q_) FR[buf_][q_] = *(const bf16x8*)FR_ADDR((grp_) * 8 + q_); } while (0)
                LD_GRP(0, 0);
#pragma unroll
                for (int gp = 0; gp < 6; ++gp) {
                    if (gp < 5) LD_GRP((gp + 1) & 1, gp + 1);
                    __builtin_amdgcn_sched_barrier(0);
#pragma unroll
                    for (int q = 0; q < 8; ++q) { const int f = gp * 8 + q; const int ks = f / 12, r = f % 12;
                        if (r < 8) aS[r] = MFMA16(FR[gp & 1][q], SB[ks], aS[r]); else aO[r - 8] = MFMA16(FR[gp & 1][q], SB[ks], aO[r - 8]); }
                    __builtin_amdgcn_sched_barrier(0);
                }
#undef LD_GRP
#undef FR_ADDR
#pragma unroll
                for (int mt = 0; mt < 8; ++mt) S[mt] = aS[mt];
                { int r0, slo, shi; chain_step_rows(chain, s, r0, slo, shi);
                  bf16_t* ob = (s >= 4) ? O + (size_t)(r0 - NCT) * 1024 : (bf16_t*)(ws + WS_ODUMP);
                  const int rs = (s >= 4) ? 1024 : 0;
#pragma unroll
                  for (int mt = 0; mt < 4; ++mt)
#pragma unroll
                      for (int e = 0; e < 4; ++e) { const int i = 16 * mt + 4 * g + e; const int rl = dir ? 63 - i : i; ob[(size_t)rl * rs + h * 128 + slice * 16 + m] = f2bf(aO[mt][e]); } }
                    raw_barrier();
                }
                for (int k = n; k < n3; ++k) raw_barrier();
            }
        }
    }
}

__device__ __forceinline__ void p4_scan(const Args& a, unsigned char* lds, int rep, const XcdBarrier& bar) {
    unsigned char* ws = a.ws; const int t = threadIdx.x, lane = t & 63, wv = t >> 6;
    unsigned* icnt = (unsigned*)(ws + WS_CTL + CTL_SCANQ) + rep * 512; volatile int* lit = (volatile int*)(lds + 147456); const unsigned xcc = xb_xcc_id() & 7u;
    __syncthreads();
    if (t == 0) { int it = -1; for (int k = 0; k < 8 && it < 0; ++k) { const unsigned x = (xcc + k) & 7u; const unsigned idx = xb_add(icnt + 64 * x, 1u); if (idx < 8u) it = (int)(x * 8u + idx); } *lit = it; }
    __syncthreads();
    const int item = *lit;
    f32x4* sv = (f32x4*)(ws + WS_SSAVE) + (size_t)(((item < 0 ? 0 : item) * 8 + wv) * 64 + lane) * 8;
    if (item >= 0) { f32x4 S[8];
#pragma unroll
        for (int i = 0; i < 8; ++i) S[i] = (f32x4){0.f, 0.f, 0.f, 0.f};
        scan_segment(a, lds, item, 0, SCAN_SPLIT, S);
#pragma unroll
        for (int i = 0; i < 8; ++i) sv[i] = S[i]; }
    { unsigned* pq = (unsigned*)(ws + WS_CTL + CTL_PREPQ);
        for (;;) {
            __syncthreads();
            if (t == 0) *lit = (int)xb_add(pq, 1u);
            __syncthreads();
            const int u = SCAN_SPLIT * 32 + *lit; if (u >= 8320) break;
            { int cwh = -1; prep_unit<1>(a, lds, u, cwh); }
        } }
    xcd_barrier(bar);
    if (item >= 0) { f32x4 S[8];
#pragma unroll
        for (int i = 0; i < 8; ++i) S[i] = sv[i];
        scan_segment(a, lds, item, SCAN_SPLIT, 260, S); }
    { unsigned* cq = (unsigned*)(ws + WS_CTL + CTL_CVTQ);
        for (;;) {
            __syncthreads();
            if (t == 0) *lit = (int)xb_add(cq, 1u);
            __syncthreads();
            const int q = CVT_SHARE0 + *lit; if (q >= MOE_CVT_UNITS) break;
            moe_cvt_unit(a, (float*)lds, q);
        } }
}

__device__ __forceinline__ void p5_gdn_out(const Args& a) {
    unsigned char* ws = a.ws; const int lane = threadIdx.x & 63, wv = threadIdx.x >> 6;
    const bf16_t* OF = (const bf16_t*)(ws + WS_OF); const bf16_t* OB = (const bf16_t*)(ws + WS_OB); const bf16_t* PROJ = (const bf16_t*)(ws + WS_PROJ); bf16_t* HB = (bf16_t*)(ws + WS_HB);
    const f32x4 on0 = *(const f32x4*)(a.gdn_onorm + (lane & 15) * 8), on1 = *(const f32x4*)(a.gdn_onorm + (lane & 15) * 8 + 4);
    const float onv[8] = {on0[0], on0[1], on0[2], on0[3], on1[0], on1[1], on1[2], on1[3]};
    u32x4 ofn[2], obn[2], zwn[2]; const int stride = gridDim.x * 8;
#define P5_LOAD(n_) do { _Pragma("unroll") for (int i_ = 0; i_ < 2; ++i_) { const size_t off_ = (size_t)(n_) * 1024 + i_ * 512 + lane * 8; \
        ofn[i_] = __builtin_nontemporal_load((const u32x4*)(OF + off_)); obn[i_] = __builtin_nontemporal_load((const u32x4*)(OB + off_)); zwn[i_] = __builtin_nontemporal_load((const u32x4*)(PROJ + (size_t)(NCT + (n_)) * 4096 + 3072 + i_ * 512 + lane * 8)); } } while (0)
    if ((int)(blockIdx.x * 8 + wv) < NL) P5_LOAD(blockIdx.x * 8 + wv);
    for (int n = blockIdx.x * 8 + wv; n < NL; n += stride) {
        u32x4 of[2], ob[2], zw[2];
#pragma unroll
        for (int i = 0; i < 2; ++i) { of[i] = ofn[i]; ob[i] = obn[i]; zw[i] = zwn[i]; }
        if (n + stride < NL) P5_LOAD(n + stride);
#pragma unroll
        for (int i = 0; i < 2; ++i) { const unsigned fw[4] = {of[i].x, of[i].y, of[i].z, of[i].w}, bw[4] = {ob[i].x, ob[i].y, ob[i].z, ob[i].w}, zz[4] = {zw[i].x, zw[i].y, zw[i].z, zw[i].w};
            float o[8]; float ss = 0.f;
#pragma unroll
            for (int q = 0; q < 4; ++q) { o[2 * q] = bflo(fw[q]) + bflo(bw[q]); o[2 * q + 1] = bfhi(fw[q]) + bfhi(bw[q]); ss += o[2 * q] * o[2 * q] + o[2 * q + 1] * o[2 * q + 1]; }
            ss += __shfl_xor(ss, 1); ss += __shfl_xor(ss, 2); ss += __shfl_xor(ss, 4); ss += __shfl_xor(ss, 8);
            const float rs = rsqrtf(ss * (1.0f / 128.0f) + 1e-6f);
            u32x4 w; unsigned wq[4];
#pragma unroll
            for (int q = 0; q < 4; ++q) wq[q] = pack2(o[2 * q] * rs * onv[2 * q] * silu_f(bflo(zz[q])), o[2 * q + 1] * rs * onv[2 * q + 1] * silu_f(bfhi(zz[q])));
            w.x = wq[0]; w.y = wq[1]; w.z = wq[2]; w.w = wq[3];
            *(u32x4*)(HB + (size_t)n * 1024 + i * 512 + lane * 8) = w; }
    }
#undef P5_LOAD
}

template <int L> __device__ __forceinline__ void p7_router(const Args& a, unsigned char* lds) {
    unsigned char* ws = a.ws; const int t = threadIdx.x, lane = t & 63, wv = t >> 6; const int m = lane & 15, g = lane >> 4;
    const float* MOD = (const float*)(ws + WS_MOD) + (size_t)L * 3 * 6144; const float* X0 = (const float*)(ws + WS_X0); bf16_t* HB = (bf16_t*)(ws + WS_HB);
    int* TOPE = (int*)(ws + WS_TOPE); float* TOPW = (float*)(ws + WS_TOPW); int* SLOT = (int*)(ws + WS_SLOT); int* CNT = (int*)(ws + WS_CTL + CTL_CNT) + L * 32;
    const float* gf = a.g_ffn + L * 1024; const float* br = a.moe_b_router + L * 32; const bf16_t* WT = (const bf16_t*)(ws + WS_WRT) + (size_t)L * 2 * 32768;
    float* gms = LDSF(0), * shv = LDSF(4096);
    int* lcnt = (int*)(lds + 65536); int* gbase = lcnt + 32; int* tokE = gbase + 32; int* tokS = tokE + 512; float* tokW = (float*)(tokS + 512);
    for (int u = blockIdx.x; u < NL / 128; u += gridDim.x) {
        const int b = (u * 128) >> 14; const float* mv = MOD + b * 6144;
        if (t < 32) lcnt[t] = 0;
        { float gv_[2], sv_[2], hv_[2];
#pragma unroll
          for (int j = 0; j < 2; ++j) { const int i = t + 512 * j; gv_[j] = gf[i]; sv_[j] = mv[4096 + i]; hv_[j] = mv[3072 + i]; }
#pragma unroll
          for (int j = 0; j < 2; ++j) { const int i = t + 512 * j; gms[i] = gv_[j] * (1.0f + sv_[j]); shv[i] = hv_[j]; } }
        __syncthreads();
        const int n0 = u * 128 + wv * 16;
        float myr = 0.f;
        f32x4 xn[2][4];
#define P7_LOAD(tt_) do { _Pragma("unroll") for (int tk_ = 0; tk_ < 2; ++tk_) { const float* xp_ = X0 + (size_t)(n0 + (tt_) + tk_) * 1024 + lane * 8; \
            _Pragma("unroll") for (int i_ = 0; i_ < 2; ++i_) { xn[tk_][2 * i_] = *(const f32x4*)(xp_ + i_ * 512); xn[tk_][2 * i_ + 1] = *(const f32x4*)(xp_ + i_ * 512 + 4); } } } while (0)
        P7_LOAD(0);
#pragma unroll 1
        for (int tt = 0; tt < 16; tt += 2) { f32x4 xv[2][4];
#pragma unroll
            for (int tk = 0; tk < 2; ++tk)
#pragma unroll
                for (int i = 0; i < 4; ++i) xv[tk][i] = xn[tk][i];
            if (tt + 2 < 16) P7_LOAD(tt + 2);
#pragma unroll
            for (int tk = 0; tk < 2; ++tk) { const int n = n0 + tt + tk; float ss = 0.f;
#pragma unroll
                for (int i = 0; i < 4; ++i) ss += xv[tk][i][0] * xv[tk][i][0] + xv[tk][i][1] * xv[tk][i][1] + xv[tk][i][2] * xv[tk][i][2] + xv[tk][i][3] * xv[tk][i][3];
                ss = wave_sum(ss); const float rstd = rsqrtf(ss * (1.0f / 1024.0f) + 1e-6f); if (lane == tt + tk) myr = rstd;
#pragma unroll
                for (int i = 0; i < 2; ++i) { const int c = i * 512 + lane * 8; const f32x4 gm0 = *(const f32x4*)(gms + c), gm1 = *(const f32x4*)(gms + c + 4), sh0 = *(const f32x4*)(shv + c), sh1 = *(const f32x4*)(shv + c + 4);
                    const f32x4 h0 = xv[tk][2 * i] * rstd * gm0 + sh0, h1 = xv[tk][2 * i + 1] * rstd * gm1 + sh1;
                    u32x4 w; w.x = pg8::cvt_pk_bf16(h0[0], h0[1]); w.y = pg8::cvt_pk_bf16(h0[2], h0[3]); w.z = pg8::cvt_pk_bf16(h1[0], h1[1]); w.w = pg8::cvt_pk_bf16(h1[2], h1[3]);
                    *(u32x4*)(HB + (size_t)n * 1024 + c) = w; } } }
#undef P7_LOAD
        const float rst = __shfl(myr, m);
        f32x4 acc[2]; acc[0] = (f32x4){0.f, 0.f, 0.f, 0.f}; acc[1] = acc[0];
        const float* xp = X0 + (size_t)(n0 + m) * 1024 + 8 * g; const bf16_t* wp = WT + (size_t)m * 1024 + 8 * g;
#pragma unroll 1
        for (int ks0 = 0; ks0 < 32; ks0 += 4) { f32x4 xa[4][2]; bf16x8 bh[4][2], bl[4][2];
#pragma unroll
            for (int j = 0; j < 4; ++j) { const int ks = ks0 + j; xa[j][0] = *(const f32x4*)(xp + 32 * ks); xa[j][1] = *(const f32x4*)(xp + 32 * ks + 4);
#pragma unroll
                for (int nt = 0; nt < 2; ++nt) { bh[j][nt] = *(const bf16x8*)(wp + (size_t)(16 * nt) * 1024 + 32 * ks); bl[j][nt] = *(const bf16x8*)(wp + 32768 + (size_t)(16 * nt) * 1024 + 32 * ks); } }
#pragma unroll
            for (int j = 0; j < 4; ++j) { const int ks = ks0 + j; const f32x4 x0 = xa[j][0], x1 = xa[j][1];
                const f32x4 g0 = *(const f32x4*)(gms + 32 * ks + 8 * g), g1 = *(const f32x4*)(gms + 32 * ks + 8 * g + 4), s0 = *(const f32x4*)(shv + 32 * ks + 8 * g), s1 = *(const f32x4*)(shv + 32 * ks + 8 * g + 4);
                const f32x4 h0 = x0 * rst * g0 + s0, h1 = x1 * rst * g1 + s1;
                u32x4 hi, lo; hi.x = pg8::cvt_pk_bf16(h0[0], h0[1]); hi.y = pg8::cvt_pk_bf16(h0[2], h0[3]); hi.z = pg8::cvt_pk_bf16(h1[0], h1[1]); hi.w = pg8::cvt_pk_bf16(h1[2], h1[3]);
                lo.x = pg8::cvt_pk_bf16(h0[0] - bflo(hi.x), h0[1] - bfhi(hi.x)); lo.y = pg8::cvt_pk_bf16(h0[2] - bflo(hi.y), h0[3] - bfhi(hi.y));
                lo.z = pg8::cvt_pk_bf16(h1[0] - bflo(hi.z), h1[1] - bfhi(hi.z)); lo.w = pg8::cvt_pk_bf16(h1[2] - bflo(hi.w), h1[3] - bfhi(hi.w));
                const bf16x8 ahi = __builtin_bit_cast(bf16x8, hi), alo = __builtin_bit_cast(bf16x8, lo);
#pragma unroll
                for (int nt = 0; nt < 2; ++nt) { acc[nt] = MFMA16(ahi, bh[j][nt], acc[nt]); acc[nt] = MFMA16(ahi, bl[j][nt], acc[nt]); acc[nt] = MFMA16(alo, bh[j][nt], acc[nt]); } } }
        const float b0 = br[m], b1 = br[16 + m];
#pragma unroll
        for (int e = 0; e < 4; ++e) { float v0 = acc[0][e] + b0, v1 = acc[1][e] + b1; int selE[4]; float selV[4];
#pragma unroll
            for (int k = 0; k < 4; ++k) { float bv; int bi; if (v1 > v0) { bv = v1; bi = 16 + m; } else { bv = v0; bi = m; }
#pragma unroll
                for (int o = 1; o <= 8; o <<= 1) { const float ov = __shfl_xor(bv, o); const int oi = __shfl_xor(bi, o); if (ov > bv || (ov == bv && oi < bi)) { bv = ov; bi = oi; } }
                selE[k] = bi; selV[k] = bv; if (bi == m) v0 = -3.0e38f; if (bi == 16 + m) v1 = -3.0e38f; }
            if (m == 0) { const int tl = wv * 16 + 4 * g + e; const float e1 = __expf(selV[1] - selV[0]), e2 = __expf(selV[2] - selV[0]), e3 = __expf(selV[3] - selV[0]); const float inv = 1.f / (1.f + e1 + e2 + e3);
                const float wk[4] = {inv, e1 * inv, e2 * inv, e3 * inv};
#pragma unroll
                for (int k = 0; k < 4; ++k) { tokE[tl * 4 + k] = selE[k]; tokW[tl * 4 + k] = wk[k]; tokS[tl * 4 + k] = atomicAdd(&lcnt[selE[k]], 1); } } }
        __syncthreads();
        if (t < 32) gbase[t] = atomicAdd(&CNT[t], lcnt[t]);
        __syncthreads();
        { const int tl = t >> 2; const int n = u * 128 + tl; const int e = tokE[t]; const int sl = gbase[e] + tokS[t]; TOPE[(size_t)n * 4 + (t & 3)] = e; TOPW[(size_t)n * 4 + (t & 3)] = tokW[t]; SLOT[(size_t)n * 4 + (t & 3)] = sl;
          ((int*)(ws + WS_ROWTOK))[(size_t)e * NL + sl] = n; }
        __syncthreads();
    }
}

template <int L> __device__ __forceinline__ void p11_combine(const Args& a, unsigned char* lds) {
    unsigned char* ws = a.ws; const int lane = threadIdx.x & 63, wv = threadIdx.x >> 6;
    const float* MOD = (const float*)(ws + WS_MOD); float* X0 = (float*)(ws + WS_X0); bf16_t* HB = (bf16_t*)(ws + WS_HB);
    const bf16_t* YS = (const bf16_t*)(ws + WS_XS); const int* TOPE = (const int*)(ws + WS_TOPE); const int* SLOT = (const int*)(ws + WS_SLOT); const float* TOPW = (const float*)(ws + WS_TOPW);
    moe_build_tables((const int*)(ws + WS_CTL + CTL_CNT) + L * 32, lds); const MoeTab* T = (const MoeTab*)(lds + MT_OFF);
    const int stride = gridDim.x * 8; const int n00 = blockIdx.x * 8 + wv;
    f32x4 gmv[4];
#pragma unroll
    for (int i = 0; i < 4; ++i) gmv[i] = *(const f32x4*)((L == 0 ? a.g_mix + 1024 : a.g_final) + i * 256 + lane * 4);
    int rowsN[2][4]; float wkN[2][4];
#define P11_IDX(nn_, tk_) do { _Pragma("unroll") for (int k_ = 0; k_ < 4; ++k_) { const int nq_ = (nn_) < NL ? (nn_) : NL - 1; rowsN[tk_][k_] = T->rb[TOPE[(size_t)nq_ * 4 + k_]] + SLOT[(size_t)nq_ * 4 + k_]; wkN[tk_][k_] = TOPW[(size_t)nq_ * 4 + k_]; } } while (0)
    P11_IDX(n00, 0); P11_IDX(n00 + stride, 1);
    for (int n0 = n00; n0 < NL; n0 += 2 * stride) {
        int rows[2][4]; float wk[2][4];
#pragma unroll
        for (int tk = 0; tk < 2; ++tk)
#pragma unroll
            for (int k = 0; k < 4; ++k) { rows[tk][k] = rowsN[tk][k]; wk[tk][k] = wkN[tk][k]; }
        u32x2 yw[2][4][4]; f32x4 xin[2][4];
#pragma unroll
        for (int tk = 0; tk < 2; ++tk) { const int n = n0 + tk * stride < NL ? n0 + tk * stride : NL - 1;
#pragma unroll
            for (int i = 0; i < 4; ++i) { const int c = i * 256 + lane * 4;
#pragma unroll
                for (int k = 0; k < 4; ++k) yw[tk][i][k] = __builtin_nontemporal_load((const u32x2*)(YS + (size_t)rows[tk][k] * 1024 + c));
                xin[tk][i] = __builtin_nontemporal_load((const f32x4*)(X0 + (size_t)n * 1024 + c)); } }
        P11_IDX(n0 + 2 * stride, 0); P11_IDX(n0 + 3 * stride, 1);
#pragma unroll
        for (int tk = 0; tk < 2; ++tk) { const int n = n0 + tk * stride; if (n >= NL) break;
            const int b = n >> 14; const float* mvL = MOD + ((size_t)L * 3 + b) * 6144; const float* mv1 = MOD + ((size_t)3 + b) * 6144;
            f32x4 g2v[4], shv_[4], scv_[4];
#pragma unroll
            for (int i = 0; i < 4; ++i) { const int c = i * 256 + lane * 4; g2v[i] = *(const f32x4*)(mvL + 5 * 1024 + c); if (L == 0) { shv_[i] = *(const f32x4*)(mv1 + c); scv_[i] = *(const f32x4*)(mv1 + 1024 + c); } }
            f32x4 xv[4]; float ss = 0.f;
#pragma unroll
            for (int i = 0; i < 4; ++i) { const int c = i * 256 + lane * 4; f32x4 y = (f32x4){0.f, 0.f, 0.f, 0.f};
#pragma unroll
                for (int k = 0; k < 4; ++k) { const u32x2 w = yw[tk][i][k]; const float wq = wk[tk][k]; y[0] += wq * bflo(w.x); y[1] += wq * bfhi(w.x); y[2] += wq * bflo(w.y); y[3] += wq * bfhi(w.y); }
                const f32x4 g2 = g2v[i]; xv[i] = xin[tk][i] + g2 * y;
                ss += xv[i][0] * xv[i][0] + xv[i][1] * xv[i][1] + xv[i][2] * xv[i][2] + xv[i][3] * xv[i][3]; }
            ss = wave_sum(ss); const float rstd = rsqrtf(ss * (1.0f / 1024.0f) + 1e-6f);
            if (L == 0) {
#pragma unroll
                for (int i = 0; i < 4; ++i) { const int c = i * 256 + lane * 4; *(f32x4*)(X0 + (size_t)n * 1024 + c) = xv[i];
                    const f32x4 gm = gmv[i], sh = shv_[i], sc = scv_[i];
                    const f32x4 hv = xv[i] * rstd * gm * (sc + 1.0f) + sh; u32x2 w; w.x = pack2(hv[0], hv[1]); w.y = pack2(hv[2], hv[3]); *(u32x2*)(HB + (size_t)n * 1024 + c) = w; }
            } else {
#pragma unroll
                for (int i = 0; i < 4; ++i) { const int c = i * 256 + lane * 4; const f32x4 gm = gmv[i]; __builtin_nontemporal_store(xv[i] * rstd * gm, (f32x4*)(a.out + (size_t)n * 1024 + c)); }
            }
        }
    }
#undef P11_IDX
}

__device__ __forceinline__ void fnet_id_frags(int lane, bf16x8& idlo, bf16x8& idhi) {
    const int m = lane & 15, g = lane >> 4;
#pragma unroll
    for (int j = 0; j < 8; ++j) { const int k = 8 * g + j; idlo[j] = (short)(k == m ? 0x3F80 : 0); idhi[j] = (short)(k == 16 + m ? 0x3F80 : 0); }
}
constexpr int FN_STG = 65536;
__device__ __forceinline__ void p12_f1(const Args& a, unsigned char* lds) {
    unsigned char* ws = a.ws; const int t = threadIdx.x, lane = t & 63, wv = t >> 6; const int m = lane & 15, g = lane >> 4;
    const bf16_t* HB = (const bf16_t*)(ws + WS_HB); bf16_t* YR = (bf16_t*)(ws + WS_YR); bf16_t* YI = (bf16_t*)(ws + WS_YI); const float* TW = (const float*)(ws + WS_TW);
    { u32x4 ftv[8];
#pragma unroll
      for (int j = 0; j < 8; ++j) ftv[j] = ((const u32x4*)(ws + WS_FT))[t + 512 * j];
#pragma unroll
      for (int j = 0; j < 8; ++j) ((u32x4*)lds)[t + 512 * j] = ftv[j]; }
    __syncthreads();
    bf16x8 idlo, idhi; fnet_id_frags(lane, idlo, idhi);
    const f32x4 z4 = (f32x4){0.f, 0.f, 0.f, 0.f}; bf16_t* stg = (bf16_t*)(lds + FN_STG);
    bf16x8 af[8];
#define F1_LOAD(u_) do { const int b_ = (u_) >> 9, n2_ = ((u_) >> 2) & 127, cb_ = (u_) & 3; const bf16_t* hp_ = HB + ((size_t)(b_ * SEQ + n2_ + 128 * m) * 1024 + cb_ * 256 + 32 * wv + 8 * g); \
        _Pragma("unroll") for (int mt_ = 0; mt_ < 8; ++mt_) af[mt_] = __builtin_nontemporal_load((const bf16x8*)(hp_ + (size_t)(128 * 16 * mt_) * 1024)); } while (0)
    if ((int)blockIdx.x < 1024) F1_LOAD((int)blockIdx.x);
    for (int u = blockIdx.x; u < 1024; u += gridDim.x) {
        const int b = u >> 9, n2 = (u >> 2) & 127, cb = u & 3; const int cw0 = cb * 256 + 32 * wv;
        u64_t pk2[2][8];
#pragma unroll
        for (int mt = 0; mt < 8; ++mt) { pk2[0][mt] = pack4(MFMA16(af[mt], idlo, z4)); pk2[1][mt] = pack4(MFMA16(af[mt], idhi, z4)); }
        if (u + (int)gridDim.x < 1024) F1_LOAD(u + (int)gridDim.x);
#pragma unroll 1
        for (int qh = 0; qh < 2; ++qh) {
            f32x4 twa[4], twb[4];
#pragma unroll
            for (int q = 0; q < 4; ++q) { const int kq = 16 * (qh * 4 + q) + 4 * g; twa[q] = *(const f32x4*)(TW + (size_t)(n2 * 128 + kq) * 2); twb[q] = *(const f32x4*)(TW + (size_t)(n2 * 128 + kq) * 2 + 4); }
#pragma unroll
            for (int nt = 0; nt < 2; ++nt) { u64_t pk[8];
#pragma unroll
                for (int mt = 0; mt < 8; ++mt) pk[mt] = pk2[nt][mt];
                f32x4 yc[4], ys[4];
#pragma unroll
                for (int q = 0; q < 4; ++q) { yc[q] = z4; ys[q] = z4; }
#pragma unroll
                for (int ks = 0; ks < 4; ++ks) { asm volatile("" ::: "memory"); const bf16x8 bop = mk_frag(pk[2 * ks], pk[2 * ks + 1]);
#pragma unroll
                    for (int q = 0; q < 4; ++q) { const unsigned char* fp = lds + (((qh * 4 + q) * 4 + ks) * 64 + lane) * 16;
                        yc[q] = MFMA16(*(const bf16x8*)fp, bop, yc[q]); ys[q] = MFMA16(*(const bf16x8*)(fp + 32768), bop, ys[q]); } }
#pragma unroll
                for (int q = 0; q < 4; ++q) { const f32x4 t01 = twa[q], t23 = twb[q];
                    const float tc[4] = {t01[0], t01[2], t23[0], t23[2]}, ts[4] = {t01[1], t01[3], t23[1], t23[3]};
#pragma unroll
                    for (int e = 0; e < 4; ++e) { const float ar = yc[q][e], ai = -ys[q][e]; const int so = (16 * q + 4 * g + e) * 256 + 32 * wv + 16 * nt + m;
                        stg[so] = f2bf(ar * tc[e] + ai * ts[e]); stg[16384 + so] = f2bf(ai * tc[e] - ar * ts[e]); } }
            }
            __syncthreads();
#pragma unroll
            for (int j = 0; j < 8; ++j) { const int p = t + 512 * j; const int pl = p >> 11, row = (p >> 5) & 63, c16 = p & 31;
                bf16_t* dst = (pl ? YI : YR) + ((size_t)(b * 128 + 64 * qh + row) * 128 + n2) * 1024 + cb * 256 + c16 * 8;
                *(u32x4*)dst = *(const u32x4*)(lds + FN_STG + (size_t)p * 16); }
            __syncthreads();
        }
    }
#undef F1_LOAD
    __syncthreads();
}
__device__ __forceinline__ void p13_f2(const Args& a, unsigned char* lds) {
    unsigned char* ws = a.ws; const int t = threadIdx.x, lane = t & 63, wv = t >> 6; const int m = lane & 15, g = lane >> 4;
    const bf16_t* YR = (const bf16_t*)(ws + WS_YR); const bf16_t* YI = (const bf16_t*)(ws + WS_YI); bf16_t* XC = (bf16_t*)(ws + WS_XCAT);
    { u32x4 ftv[8];
#pragma unroll
      for (int j = 0; j < 8; ++j) ftv[j] = ((const u32x4*)(ws + WS_FT))[t + 512 * j];
#pragma unroll
      for (int j = 0; j < 8; ++j) ((u32x4*)lds)[t + 512 * j] = ftv[j]; }
    __syncthreads();
    bf16x8 idlo, idhi; fnet_id_frags(lane, idlo, idhi);
    const f32x4 z4 = (f32x4){0.f, 0.f, 0.f, 0.f}; bf16_t* stg = (bf16_t*)(lds + FN_STG);
    bf16x8 afr[8], afi[8];
#define F2_LOAD(u_) do { const int b_ = (u_) >> 9, k1_ = ((u_) >> 2) & 127, cb_ = (u_) & 3; const size_t ro_ = ((size_t)(b_ * 128 + k1_) * 128 + m) * 1024 + cb_ * 256 + 32 * wv + 8 * g; \
        _Pragma("unroll") for (int mt_ = 0; mt_ < 8; ++mt_) { afr[mt_] = __builtin_nontemporal_load((const bf16x8*)(YR + ro_ + (size_t)(16 * mt_) * 1024)); afi[mt_] = __builtin_nontemporal_load((const bf16x8*)(YI + ro_ + (size_t)(16 * mt_) * 1024)); } } while (0)
    if ((int)blockIdx.x < 1024) F2_LOAD((int)blockIdx.x);
    for (int u = blockIdx.x; u < 1024; u += gridDim.x) {
        const int b = u >> 9, k1 = (u >> 2) & 127, cb = u & 3; const int cw0 = cb * 256 + 32 * wv;
        u64_t pr2[2][8], pi2[2][8];
#pragma unroll
        for (int mt = 0; mt < 8; ++mt) { pr2[0][mt] = pack4(MFMA16(afr[mt], idlo, z4)); pr2[1][mt] = pack4(MFMA16(afr[mt], idhi, z4)); pi2[0][mt] = pack4(MFMA16(afi[mt], idlo, z4)); pi2[1][mt] = pack4(MFMA16(afi[mt], idhi, z4)); }
        if (u + (int)gridDim.x < 1024) F2_LOAD(u + (int)gridDim.x);
#pragma unroll 1
        for (int qh = 0; qh < 2; ++qh) {
#pragma unroll
            for (int nt = 0; nt < 2; ++nt) { u64_t pr[8], pi[8];
#pragma unroll
                for (int mt = 0; mt < 8; ++mt) { pr[mt] = pr2[nt][mt]; pi[mt] = pi2[nt][mt]; }
                f32x4 xr[4], xi[4], xn[4];
#pragma unroll
                for (int q = 0; q < 4; ++q) { xr[q] = z4; xi[q] = z4; xn[q] = z4; }
#pragma unroll
                for (int ks = 0; ks < 4; ++ks) { asm volatile("" ::: "memory"); const bf16x8 br = mk_frag(pr[2 * ks], pr[2 * ks + 1]), bi = mk_frag(pi[2 * ks], pi[2 * ks + 1]);
#pragma unroll
                    for (int q = 0; q < 4; ++q) { const unsigned char* fp = lds + (((qh * 4 + q) * 4 + ks) * 64 + lane) * 16; const bf16x8 cf = *(const bf16x8*)fp, sf = *(const bf16x8*)(fp + 32768);
                        xr[q] = MFMA16(cf, br, xr[q]); xr[q] = MFMA16(sf, bi, xr[q]); xi[q] = MFMA16(cf, bi, xi[q]); xn[q] = MFMA16(sf, br, xn[q]); } }
#pragma unroll
                for (int q = 0; q < 4; ++q)
#pragma unroll
                    for (int e = 0; e < 4; ++e) { const int so = (16 * q + 4 * g + e) * 256 + 32 * wv + 16 * nt + m; stg[so] = f2bf(xr[q][e]); stg[16384 + so] = f2bf(xi[q][e] - xn[q][e]); }
            }
            __syncthreads();
#pragma unroll
            for (int j = 0; j < 8; ++j) { const int p = t + 512 * j; const int pl = p >> 11, row = (p >> 5) & 63, c16 = p & 31;
                bf16_t* dst = XC + ((size_t)b * SEQ + k1 + 128 * (64 * qh + row)) * 2048 + pl * 1024 + cb * 256 + c16 * 8;
                *(u32x4*)dst = *(const u32x4*)(lds + FN_STG + (size_t)p * 16); }
            __syncthreads();
        }
    }
#undef F2_LOAD
    __syncthreads();
}

constexpr int NPHASE = 20;
#ifndef REP_MASK
#define REP_MASK 0ull
#endif
#define PHASE_IF(k) for (int r_ = 0, n_ = IN(k) ? 1 + (int)(((unsigned long long)(REP_MASK) >> (k)) & 1ull) : 0; r_ < n_; (++r_ < n_) ? xcd_barrier(bar) : (void)0)
template <int L> __device__ __forceinline__ void moe_phases(const Args& args, unsigned char* lds, int lo, int hi, int base, const XcdBarrier& bar) {
#define IN(k) (lo <= (k) && (k) < hi)
#define SEAM(k) do { if (IN(k) && IN((k) + 1)) xcd_barrier(bar); } while (0)
    unsigned char* ws = args.ws;
    PHASE_IF(base + 0) p7_router<L>(args, lds);
    SEAM(base + 0);
    PHASE_IF(base + 2) {
        const int* CNT = (const int*)(ws + WS_CTL + CTL_CNT) + L * 32; moe_build_tables(CNT, lds);
        pg8::Gemm g{(const bf16_t*)(ws + WS_HB), (const bf16_t*)(ws + WS_BTGU) + (size_t)L * 32 * 2048 * 1024, MAXROWS, 2048, 1024};
        MoeOrder S{(int)gridDim.x, (int)blockIdx.x, 8, (const MoeTab*)(lds + MT_OFF), (const int*)(lds + RT_OFF), 2048u, 0};
        moe_build_rowtab(S, (const int*)(ws + WS_ROWTOK), lds);
        EpiGLU E{(bf16_t*)(ws + WS_ACT), args.moe_b_gu + (size_t)L * 32 * 2048};
        pg8::gemm_phase_ga<EpiGLU, MoeOrder, false>((PG8_LAS unsigned char*)lds, g, S, E, nullptr);
    }
    SEAM(base + 2);
    PHASE_IF(base + 3) {
        const int* CNT = (const int*)(ws + WS_CTL + CTL_CNT) + L * 32; moe_build_tables(CNT, lds);
        pg8::Gemm g{(const bf16_t*)(ws + WS_ACT), (const bf16_t*)(ws + WS_BTDN) + (size_t)L * 32 * 1024 * 1024, MAXROWS, 1024, 1024};
        MoeOrderR S{(int)gridDim.x, (int)blockIdx.x, 4, (const MoeTab*)(lds + MT_OFF), (const int*)(ws + WS_ROWTOK), 2048u, 0};
        EpiDown E{(bf16_t*)(ws + WS_XS), args.moe_b_down + (size_t)L * 32 * 1024};
        pg8::gemm_phase<EpiDown, MoeOrderR, false>((PG8_LAS unsigned char*)lds, g, S, E, nullptr);
    }
    SEAM(base + 3);
    PHASE_IF(base + 4) p11_combine<L>(args, lds);
    SEAM(base + 4);
#undef SEAM
#undef IN
}

__global__ void __launch_bounds__(NTHR, 2) mk_fwd(Args args) {
    extern __shared__ __attribute__((aligned(16))) unsigned char lds[];
    unsigned char* ws = args.ws;
    const int lo = args.ph_lo, hi = args.ph_hi;
#define IN(k) (lo <= (k) && (k) < hi)
#define SEAM(k) do { if (IN(k) && IN((k) + 1)) xcd_barrier(bar); } while (0)
    volatile LAS unsigned* xbw = (volatile LAS unsigned*)(lds + LDS_BYTES - 16);
    if (threadIdx.x < 4) xbw[threadIdx.x] = 0u;
    __syncthreads();
    XcdBarrier bar; bar.bar = (unsigned*)(ws + WS_CTL); bar.x = 0; bar.st = xbw;
    if (hi - lo > 1) bar = xcd_barrier_post((unsigned*)(ws + WS_CTL), xbw);
    PHASE_IF(0) p0_prologue(args, lds);
    SEAM(0);
    PHASE_IF(1) p1_embed(args);
    SEAM(1);
    PHASE_IF(2) {
        pg8::Gemm g{(const bf16_t*)(ws + WS_HB), (const bf16_t*)(ws + WS_BTIN), TALL, GINP, 1024};
        pg8::StaticOrder S; S.init(TALL, GINP, (int)gridDim.x, (int)blockIdx.x);
        EpiProj E{(bf16_t*)(ws + WS_PROJ), (float*)(ws + WS_GATES)};
        pg8::gemm_phase<EpiProj, pg8::StaticOrder, false>((PG8_LAS unsigned char*)lds, g, S, E, nullptr);
    }
    SEAM(2);
    PHASE_IF(3) p3_prep(args, lds);
    SEAM(3);
    PHASE_IF(4) p4_scan(args, lds, r_, bar);
    SEAM(4);
    PHASE_IF(5) p5_gdn_out(args);
    SEAM(5);
    PHASE_IF(6) {
        pg8::Gemm g{(const bf16_t*)(ws + WS_HB), (const bf16_t*)(ws + WS_BTOUT), NL, 1024, 1024};
        pg8::StaticOrder S; S.init(NL, 1024, (int)gridDim.x, (int)blockIdx.x);
        EpiResid0 E{(float*)(ws + WS_X0), args.x, (const float*)(ws + WS_POSR), (const float*)(ws + WS_POSC), (const float*)(ws + WS_MOD) + 2048};
        pg8::gemm_phase<EpiResid0, pg8::StaticOrder, false>((PG8_LAS unsigned char*)lds, g, S, E, nullptr);
    }
    SEAM(6);
    moe_phases<0>(args, lds, lo, hi, 7, bar);
    PHASE_IF(12) p12_f1(args, lds);
    SEAM(12);
    PHASE_IF(13) p13_f2(args, lds);
    SEAM(13);
    PHASE_IF(14) {
        pg8::Gemm g{(const bf16_t*)(ws + WS_XCAT), (const bf16_t*)(ws + WS_BTFN), NL, 1024, 2048};
        pg8::StaticOrder S; S.init(NL, 1024, (int)gridDim.x, (int)blockIdx.x);
        EpiResid E{(float*)(ws + WS_X0), (const float*)(ws + WS_MOD) + 3 * 6144 + 2048};
        pg8::gemm_phase<EpiResid, pg8::StaticOrder, false>((PG8_LAS unsigned char*)lds, g, S, E, nullptr);
    }
    SEAM(14);
    moe_phases<1>(args, lds, lo, hi, 15, bar);
#undef SEAM
#undef IN
}

extern "C" void kernel_launch(void* const* d_in, const int* in_sizes, int n_in, void* d_out, int out_size, void* d_ws, size_t ws_size, hipStream_t stream) {
    static int grid = 0;
    if (grid == 0) {
        int dev = 0, cus = 0;
        if (hipGetDevice(&dev) != hipSuccess || hipDeviceGetAttribute(&cus, hipDeviceAttributeMultiprocessorCount, dev) != hipSuccess) { fprintf(stderr, "kernel_launch: device query failed\n"); grid = -1; return; }
        if (hipFuncSetAttribute((const void*)mk_fwd, hipFuncAttributeMaxDynamicSharedMemorySize, LDS_BYTES) != hipSuccess) { fprintf(stderr, "kernel_launch: hipFuncSetAttribute failed\n"); grid = -1; return; }
        if (n_in != 22 || ws_size < WS_END) { fprintf(stderr, "kernel_launch: unexpected n_in %d or ws_size %zu < %zu\n", n_in, ws_size, (size_t)WS_END); grid = -1; return; }
        grid = cus;
    }
    if (grid < 0) return;
    (void)hipMemsetAsync((char*)d_ws + WS_CTL, 0, CTL_BYTES, stream);
    Args a{};
    const float** fp = (const float**)&a;
    for (int i = 0; i < 22; ++i) fp[i] = (const float*)d_in[i];
    a.out = (float*)d_out; a.ws = (unsigned char*)d_ws;
#if defined(MK_PER_PHASE)
    for (int ph = 0; ph < NPHASE; ++ph) { a.ph_lo = ph; a.ph_hi = ph + 1; hipLaunchKernelGGL(mk_fwd, dim3(grid), dim3(NTHR), LDS_BYTES, stream, a); }
#else
    a.ph_lo = 0; a.ph_hi = NPHASE; hipLaunchKernelGGL(mk_fwd, dim3(grid), dim3(NTHR), LDS_BYTES, stream, a);
#endif
}
```

```cpp
#include <cstdio>
#include <cstdint>
#include <hip/hip_runtime.h>
namespace pg8 {
#define PG8_LAS __attribute__((address_space(3)))
typedef unsigned short bf16_t;
typedef short bf16x8 __attribute__((ext_vector_type(8)));
typedef float f32x4 __attribute__((ext_vector_type(4)));
typedef unsigned u32x4 __attribute__((ext_vector_type(4)));
constexpr int BM = 256, BK = 64, HALF = 128, HTB = HALF * BK * 2  , STAGE_BYTES = 8 * HTB, NXCD = 8, WGM = 8;

__host__ __device__ __forceinline__ int lds_byte(int r, int c) { const int st = (r >> 4) * 2 + (c >> 5), rr = r & 15, cc = c & 31, ob = rr * 64 + cc * 2; return st * 1024 + (ob ^ (((ob >> 9) & 1) << 5)); }
__host__ __device__ __forceinline__ void stage_rc(int b, int& R, int& C) { const int st = b / 1024, sb = b % 1024, swz = sb ^ (((sb >> 9) & 1) << 5); R = (st >> 1) * 16 + swz / 64; C = (st & 1) * 32 + (swz % 64) / 2; }
__host__ __device__ __forceinline__ int perm32(int rho) { const int n = rho >> 4, i = rho & 15; return 8 * (i >> 2) + 4 * n + (i & 3); }

struct Unit { int pm, pn; };
struct Gemm { const bf16_t* A; const bf16_t* Bt; int M, N, K; };

struct StaticOrder {
    int nM, nN, nwg, G, c;
    __host__ __device__ void init(int M, int N, int G_, int c_) { nM = M / BM; nN = N / BM; nwg = nM * nN; G = G_; c = c_; }
    __host__ __device__ bool next(int i, Unit& u) const {
        const long L = (long)i * G + c; if (L >= nwg) return false;
        int wgid = (int)L; { const int q = nwg / NXCD, r = nwg % NXCD, xcd = wgid % NXCD, off = wgid / NXCD; wgid = (xcd < r ? xcd * (q + 1) : r * (q + 1) + (xcd - r) * q) + off; }
        const int nig = WGM * nN, gid = wgid / nig, fm = gid * WGM, gsz = (nM - fm) < WGM ? (nM - fm) : WGM;
        u.pm = fm + ((wgid % nig) % gsz); u.pn = (wgid % nig) / gsz; return true;
    }
    __device__ __forceinline__ void a_ready(const Unit&) const {}
    __device__ __forceinline__ void done(const Unit&) const {}
};
struct CountedOrder : StaticOrder {
    const unsigned* ready; unsigned need; unsigned* tmo;
    __device__ __forceinline__ void a_ready(const Unit& u) const {
        if (threadIdx.x < 64) {
            const unsigned long long t0 = __builtin_amdgcn_s_memrealtime(); unsigned polls = 0;
            while ((unsigned)__builtin_amdgcn_readfirstlane(__hip_atomic_load(ready + 64 * u.pm, __ATOMIC_RELAXED, __HIP_MEMORY_SCOPE_AGENT)) < need) {
                if ((++polls & 255u) == 0u && __builtin_amdgcn_readfirstlane(__hip_atomic_load(tmo, __ATOMIC_RELAXED, __HIP_MEMORY_SCOPE_AGENT)) != 0u) break;
                if (__builtin_amdgcn_s_memrealtime() - t0 > 2000000ull) {
                    if (threadIdx.x == 0) { unsigned expect = 0u; __hip_atomic_compare_exchange_strong(tmo + 1, &expect, 0x600u | (unsigned)(u.pm & 0xff), __ATOMIC_RELAXED, __ATOMIC_RELAXED, __HIP_MEMORY_SCOPE_AGENT); __hip_atomic_store(tmo, 1u, __ATOMIC_RELAXED, __HIP_MEMORY_SCOPE_AGENT); }
                    break; }
                __builtin_amdgcn_s_sleep(2); }
            __builtin_amdgcn_fence(__ATOMIC_ACQUIRE, "agent");
            asm volatile("s_waitcnt vmcnt(0)" ::: "memory");
        }
#if !defined(BROKEN_HOOK_NO_BARRIER)
        asm volatile("" ::: "memory"); __builtin_amdgcn_s_barrier(); asm volatile("" ::: "memory");
#endif
    }
};

typedef float f32x2c __attribute__((ext_vector_type(2)));
typedef __bf16 bf16x2c __attribute__((ext_vector_type(2)));
__device__ __forceinline__ unsigned cvt_pk_bf16(float lo, float hi) { const f32x2c v = {lo, hi}; const bf16x2c r = __builtin_convertvector(v, bf16x2c); return __builtin_bit_cast(unsigned, r); }
typedef float f32x2 __attribute__((ext_vector_type(2)));
__device__ __forceinline__ f32x2 gelu_pk(f32x2 v) {
    const f32x2 av = __builtin_elementwise_abs(v), d = av * 0.2316418882f + 1.0f;
    f32x2 t; t.x = __builtin_amdgcn_rcpf(d.x); t.y = __builtin_amdgcn_rcpf(d.y);
    f32x2 q = t * 0.5307027145f + (-0.7265760135f); q = q * t + 0.7107068705f; q = q * t + (-0.142248368f); q = q * t + 0.127414796f; q = q * t;
    const f32x2 s = (v * v) * (-0.72134752044f);
    f32x2 e; e.x = __builtin_amdgcn_exp2f(s.x); e.y = __builtin_amdgcn_exp2f(s.y);
    const f32x2 m = v * (q * e), r = v - m;
    f32x2 o; o.x = v.x < 0.f ? m.x : r.x; o.y = v.y < 0.f ? m.y : r.y; return o;
}

struct EpiF32 {
    static constexpr bool PERM = false, AFTER_DRAIN = false, HAS_PRE = false;
    float* C; int ldc; const float* bias;
    __device__ __forceinline__ void operator()(const f32x4 (&acc)[2][2][4][2], const Unit& u, int wr, int wc, int fr, int fq) const {
        const int row0 = u.pm * BM + wr * 64 + fr, col0 = u.pn * BM + wc * 32 + 4 * fq;
        f32x4 bv[2][2];
#pragma unroll
        for (int bj = 0; bj < 2; ++bj)
#pragma unroll
            for (int n = 0; n < 2; ++n) bv[bj][n] = bias ? *(const f32x4*)(bias + col0 + bj * HALF + n * 16) : (f32x4){0.f, 0.f, 0.f, 0.f};
#pragma unroll
        for (int ai = 0; ai < 2; ++ai)
#pragma unroll
            for (int m = 0; m < 4; ++m) { float* rowp = C + (size_t)(row0 + ai * HALF + m * 16) * ldc + col0;
#pragma unroll
                for (int bj = 0; bj < 2; ++bj)
#pragma unroll
                    for (int n = 0; n < 2; ++n) *(f32x4*)(rowp + bj * HALF + n * 16) = acc[ai][bj][m][n] + bv[bj][n]; }
    }
};
template <int ACT  > struct EpiBf16 {
    static constexpr bool PERM = true, AFTER_DRAIN = false, HAS_PRE = false;
    bf16_t* O; int ldc; const float* bias; int split_cols; size_t split_stride;
    __device__ __forceinline__ void operator()(const f32x4 (&acc)[2][2][4][2], const Unit& u, int wr, int wc, int fr, int fq) const {
        const int row0 = u.pm * BM + wr * 64 + fr; int colt = u.pn * BM; bf16_t* base = O;
        if (split_cols) { const int t = colt / split_cols; base += (size_t)t * split_stride; colt -= t * split_cols; }
        const int col0 = colt + wc * 32 + 8 * fq, bcol0 = u.pn * BM + wc * 32 + 8 * fq;
        f32x4 bv[2][2];
#pragma unroll
        for (int bj = 0; bj < 2; ++bj)
#pragma unroll
            for (int n = 0; n < 2; ++n) bv[bj][n] = bias ? *(const f32x4*)(bias + bcol0 + bj * HALF + 4 * n) : (f32x4){0.f, 0.f, 0.f, 0.f};
#pragma unroll
        for (int ai = 0; ai < 2; ++ai)
#pragma unroll
            for (int m = 0; m < 4; ++m) { bf16_t* rowp = base + (size_t)(row0 + ai * HALF + m * 16) * ldc + col0;
#pragma unroll
                for (int bj = 0; bj < 2; ++bj) { f32x4 v0 = acc[ai][bj][m][0] + bv[bj][0], v1 = acc[ai][bj][m][1] + bv[bj][1];
                    if (ACT == 1) { f32x2 a = gelu_pk((f32x2){v0[0], v0[1]}), b = gelu_pk((f32x2){v0[2], v0[3]}), c = gelu_pk((f32x2){v1[0], v1[1]}), d = gelu_pk((f32x2){v1[2], v1[3]});
                        v0 = (f32x4){a.x, a.y, b.x, b.y}; v1 = (f32x4){c.x, c.y, d.x, d.y}; }
                    if (ACT == 2) {
#pragma unroll
                        for (int j = 0; j < 4; ++j) { v0[j] = 0.5f * v0[j] * (1.0f + erff(v0[j] * 0.70710678f)); v1[j] = 0.5f * v1[j] * (1.0f + erff(v1[j] * 0.70710678f)); } }
                    u32x4 w; w.x = cvt_pk_bf16(v0[0], v0[1]); w.y = cvt_pk_bf16(v0[2], v0[3]); w.z = cvt_pk_bf16(v1[0], v1[1]); w.w = cvt_pk_bf16(v1[2], v1[3]);
                    *(u32x4*)(rowp + bj * HALF) = w; } }
    }
};

template <class Epi, class Sched, bool STAMP = false>
__device__ __forceinline__ void gemm_phase(PG8_LAS unsigned char* lds, const Gemm g, const Sched& S, const Epi& E, unsigned long long* stamps) {
    const int tid = threadIdx.x, wid = __builtin_amdgcn_readfirstlane(tid >> 6), lane = tid & 63, wr = wid >> 2, wc = wid & 3, fr = lane & 15, fq = lane >> 4;
    const int K = g.K, nt = K / BK;
    int ts_lo = 0, ts_hi = 0, nts = 0; const unsigned long long rt_entry = STAMP ? (unsigned long long)wall_clock64() : 0ull;
#define PG8_STAMP() do { if (STAMP && wid == 0 && nts < 64) { const unsigned long long _c = (unsigned long long)clock64(); \
        ts_lo = (lane == nts) ? (int)(unsigned)_c : ts_lo; ts_hi = (lane == nts) ? (int)(unsigned)(_c >> 32) : ts_hi; ++nts; } } while (0)
    PG8_STAMP();
    unsigned voffA[2], voffB[2];
#pragma unroll
    for (int i = 0; i < 2; ++i) { int R, C; stage_rc(tid * 16 + i * 8192, R, C); const int Rb = Epi::PERM ? ((R & ~31) + perm32(R & 31)) : R;
        voffA[i] = (unsigned)(R * K + C) * 2u; voffB[i] = (unsigned)(Rb * K + C) * 2u; }
    const size_t kstep = (size_t)(BK * 2);
    const size_t hstep = (size_t)HALF * K * 2;
    const size_t tstep = 2 * hstep;
    const unsigned ldsw = (unsigned)wid * 1024u;
    const int aoff = lds_byte(wr * 64 + fr, fq * 8), boff = lds_byte(wc * 32 + fr, fq * 8);
#define PG8_SA(b, h) (((b) * 2 + (h)) * HTB)
#define PG8_SB(b, h) ((4 + (b) * 2 + (h)) * HTB)
#define PG8_STAGE(bufoff, gbase, voff) do { _Pragma("unroll") for (int _i = 0; _i < 2; ++_i) \
        __builtin_amdgcn_global_load_lds((const unsigned*)((const char*)(gbase) + (voff)[_i]), (PG8_LAS unsigned*)(lds + (bufoff) + ldsw + _i * 8192), 16, 0, 0); } while (0)
#define PG8_LDA(dst, b, h) do { _Pragma("unroll") for (int m = 0; m < 4; ++m) _Pragma("unroll") for (int k = 0; k < 2; ++k) dst[m][k] = *(const PG8_LAS bf16x8*)(lds + PG8_SA(b, h) + aoff + m * 2048 + k * 1024); } while (0)
#define PG8_LDB(dst, b, h) do { _Pragma("unroll") for (int n = 0; n < 2; ++n) _Pragma("unroll") for (int k = 0; k < 2; ++k) dst[n][k] = *(const PG8_LAS bf16x8*)(lds + PG8_SB(b, h) + boff + n * 2048 + k * 1024); } while (0)
#define PG8_MMA(ai, bj, At, Bt) do { __builtin_amdgcn_s_setprio(1); _Pragma("unroll") for (int m = 0; m < 4; ++m) _Pragma("unroll") for (int n = 0; n < 2; ++n) _Pragma("unroll") for (int k = 0; k < 2; ++k) \
        acc[ai][bj][m][n] = __builtin_amdgcn_mfma_f32_16x16x32_bf16(Bt[n][k], At[m][k], acc[ai][bj][m][n], 0, 0, 0); __builtin_amdgcn_s_setprio(0); } while (0)
#define PG8_WAIT_V(n) asm volatile("s_waitcnt vmcnt(" #n ")" ::: "memory")
#define PG8_WAIT_L(n) asm volatile("s_waitcnt lgkmcnt(" #n ")" ::: "memory")
#define PG8_BAR __builtin_amdgcn_s_barrier()
#define PG8_SCHED __builtin_amdgcn_sched_barrier(0)
    Unit cur, nxt; int ui = 0;
    if (!S.next(0, cur)) return;
    f32x4 acc[2][2][4][2];
#pragma unroll
    for (int a = 0; a < 2; ++a)
#pragma unroll
        for (int b = 0; b < 2; ++b)
#pragma unroll
            for (int m = 0; m < 4; ++m)
#pragma unroll
                for (int n = 0; n < 2; ++n) acc[a][b][m][n] = (f32x4){0.f, 0.f, 0.f, 0.f};
    bf16x8 At[4][2], B0[2][2], B1[2][2];
    const char* cA = (const char*)g.A + (size_t)cur.pm * tstep; const char* cB = (const char*)g.Bt + (size_t)cur.pn * tstep;
    S.a_ready(cur);
    PG8_STAGE(PG8_SB(0, 0), cB, voffB); PG8_STAGE(PG8_SA(0, 0), cA, voffA); PG8_STAGE(PG8_SB(0, 1), cB + hstep, voffB); PG8_STAGE(PG8_SA(0, 1), cA + hstep, voffA);
    if (wr == 1) PG8_BAR;
    PG8_WAIT_V(4); PG8_BAR;
    PG8_STAGE(PG8_SB(1, 0), cB + kstep, voffB); PG8_STAGE(PG8_SA(1, 0), cA + kstep, voffA); PG8_STAGE(PG8_SB(1, 1), cB + hstep + kstep, voffB);
    PG8_WAIT_V(6); PG8_BAR;
    PG8_STAMP();
    for (;;) {
        const bool has_next = S.next(ui + 1, nxt);
        if constexpr (Epi::HAS_PRE) E.pre(cur, wr, wc, fr, fq);
        const char* nA = has_next ? (const char*)g.A + (size_t)nxt.pm * tstep : cA; const char* nB = has_next ? (const char*)g.Bt + (size_t)nxt.pn * tstep : cB;
        for (int t = 0; t < nt; t += 2) {
            const bool last = (t == nt - 2);
            const char* a1 = cA + (size_t)(t + 1) * kstep;
            const char* a2 = last ? nA : cA + (size_t)(t + 2) * kstep; const char* b2 = last ? nB : cB + (size_t)(t + 2) * kstep;
            const char* a3 = a2 + kstep; const char* b3 = b2 + kstep;
            if (last && has_next) S.a_ready(nxt);
            PG8_LDB(B0, 0, 0); PG8_SCHED; PG8_LDA(At, 0, 0); PG8_STAGE(PG8_SA(1, 1), a1 + hstep, voffA);
            PG8_WAIT_L(8); PG8_BAR; PG8_WAIT_L(0); PG8_MMA(0, 0, At, B0); PG8_BAR; PG8_SCHED;
            PG8_LDB(B1, 0, 1); PG8_STAGE(PG8_SB(0, 0), b2, voffB);
            PG8_BAR; PG8_WAIT_L(0); PG8_MMA(0, 1, At, B1); PG8_BAR;
            PG8_LDA(At, 0, 1); PG8_STAGE(PG8_SA(0, 0), a2, voffA);
            PG8_BAR; PG8_WAIT_L(0); PG8_MMA(1, 0, At, B0); PG8_BAR; PG8_SCHED;
            PG8_STAGE(PG8_SB(0, 1), b2 + hstep, voffB);
            PG8_WAIT_V(6); PG8_BAR; PG8_MMA(1, 1, At, B1); PG8_BAR;
            PG8_LDB(B0, 1, 0); PG8_SCHED; PG8_LDA(At, 1, 0); PG8_STAGE(PG8_SA(0, 1), a2 + hstep, voffA);
            PG8_WAIT_L(8); PG8_BAR; PG8_WAIT_L(0); PG8_MMA(0, 0, At, B0); PG8_BAR; PG8_SCHED;
            PG8_LDB(B1, 1, 1); PG8_STAGE(PG8_SB(1, 0), b3, voffB);
            PG8_BAR; PG8_WAIT_L(0); PG8_MMA(0, 1, At, B1); PG8_BAR;
            PG8_LDA(At, 1, 1); PG8_STAGE(PG8_SA(1, 0), a3, voffA);
            PG8_BAR; PG8_WAIT_L(0); PG8_MMA(1, 0, At, B0); PG8_BAR; PG8_SCHED;
            PG8_STAGE(PG8_SB(1, 1), b3 + hstep, voffB);
            PG8_WAIT_V(6); PG8_BAR; PG8_MMA(1, 1, At, B1); PG8_BAR;
        }
        PG8_STAMP();
        if constexpr (!Epi::AFTER_DRAIN) { E(acc, cur, wr, wc, fr, fq); S.done(cur); }
        PG8_STAMP();
        if (!has_next) break;
#pragma unroll
        for (int a = 0; a < 2; ++a)
#pragma unroll
            for (int b = 0; b < 2; ++b)
#pragma unroll
                for (int m = 0; m < 4; ++m)
#pragma unroll
                    for (int n = 0; n < 2; ++n) acc[a][b][m][n] = (f32x4){0.f, 0.f, 0.f, 0.f};
        cur = nxt; cA = nA; cB = nB; ++ui;
    }
    PG8_WAIT_V(0);
    if (wr == 0) PG8_BAR;
    PG8_BAR;
    if constexpr (Epi::AFTER_DRAIN) { E.fused(acc, cur, wr, wc, fr, fq, lds, wid, lane); S.done(cur); }
    PG8_STAMP();
    if (STAMP && wid == 0) { stamps[lane] = lane < nts ? (((unsigned long long)(unsigned)ts_hi << 32) | (unsigned)ts_lo) : 0ull;
        if (lane == 62) stamps[62] = rt_entry; if (lane == 63) stamps[63] = (unsigned long long)wall_clock64(); }
#undef PG8_STAMP
#undef PG8_SA
#undef PG8_SB
#undef PG8_STAGE
#undef PG8_LDA
#undef PG8_LDB
#undef PG8_MMA
#undef PG8_WAIT_V
#undef PG8_WAIT_L
#undef PG8_BAR
#undef PG8_SCHED
}
template <class Epi, class Sched, bool STAMP = false>
__device__ __forceinline__ void gemm_phase_ga(PG8_LAS unsigned char* lds, const Gemm g, const Sched& S, const Epi& E, unsigned long long* stamps) {
    const int tid = threadIdx.x, wid = __builtin_amdgcn_readfirstlane(tid >> 6), lane = tid & 63, wr = wid >> 2, wc = wid & 3, fr = lane & 15, fq = lane >> 4;
    const int K = g.K, nt = K / BK;
    int ts_lo = 0, ts_hi = 0, nts = 0; const unsigned long long rt_entry = STAMP ? (unsigned long long)wall_clock64() : 0ull;
#define PG8_STAMP() do { if (STAMP && wid == 0 && nts < 64) { const unsigned long long _c = (unsigned long long)clock64(); \
        ts_lo = (lane == nts) ? (int)(unsigned)_c : ts_lo; ts_hi = (lane == nts) ? (int)(unsigned)(_c >> 32) : ts_hi; ++nts; } } while (0)
    PG8_STAMP();
    unsigned voffB[2]; int RA_[2]; unsigned CA2_[2];
#pragma unroll
    for (int i = 0; i < 2; ++i) { int R, C; stage_rc(tid * 16 + i * 8192, R, C); const int Rb = Epi::PERM ? ((R & ~31) + perm32(R & 31)) : R;
        RA_[i] = R; CA2_[i] = (unsigned)C * 2u; voffB[i] = (unsigned)(Rb * K + C) * 2u; }
    const size_t kstep = (size_t)(BK * 2);
    const size_t hstep = (size_t)HALF * K * 2;
    const size_t tstep = 2 * hstep;
    const unsigned ldsw = (unsigned)wid * 1024u;
    const int aoff = lds_byte(wr * 64 + fr, fq * 8), boff = lds_byte(wc * 32 + fr, fq * 8);
#define PG8_SA(b, h) (((b) * 2 + (h)) * HTB)
#define PG8_SB(b, h) ((4 + (b) * 2 + (h)) * HTB)
#define PG8_STAGE(bufoff, gbase, voff) do { _Pragma("unroll") for (int _i = 0; _i < 2; ++_i) \
        __builtin_amdgcn_global_load_lds((const unsigned*)((const char*)(gbase) + (voff)[_i]), (PG8_LAS unsigned*)(lds + (bufoff) + ldsw + _i * 8192), 16, 0, 0); } while (0)
#define PG8_LDA(dst, b, h) do { _Pragma("unroll") for (int m = 0; m < 4; ++m) _Pragma("unroll") for (int k = 0; k < 2; ++k) dst[m][k] = *(const PG8_LAS bf16x8*)(lds + PG8_SA(b, h) + aoff + m * 2048 + k * 1024); } while (0)
#define PG8_LDB(dst, b, h) do { _Pragma("unroll") for (int n = 0; n < 2; ++n) _Pragma("unroll") for (int k = 0; k < 2; ++k) dst[n][k] = *(const PG8_LAS bf16x8*)(lds + PG8_SB(b, h) + boff + n * 2048 + k * 1024); } while (0)
#define PG8_MMA(ai, bj, At, Bt) do { __builtin_amdgcn_s_setprio(1); _Pragma("unroll") for (int m = 0; m < 4; ++m) _Pragma("unroll") for (int n = 0; n < 2; ++n) _Pragma("unroll") for (int k = 0; k < 2; ++k) \
        acc[ai][bj][m][n] = __builtin_amdgcn_mfma_f32_16x16x32_bf16(Bt[n][k], At[m][k], acc[ai][bj][m][n], 0, 0, 0); __builtin_amdgcn_s_setprio(0); } while (0)
#define PG8_WAIT_V(n) asm volatile("s_waitcnt vmcnt(" #n ")" ::: "memory")
#define PG8_WAIT_L(n) asm volatile("s_waitcnt lgkmcnt(" #n ")" ::: "memory")
#define PG8_BAR __builtin_amdgcn_s_barrier()
#define PG8_SCHED __builtin_amdgcn_sched_barrier(0)
    Unit cur, nxt; int ui = 0;
    if (!S.next(0, cur)) return;
    f32x4 acc[2][2][4][2];
#pragma unroll
    for (int a = 0; a < 2; ++a)
#pragma unroll
        for (int b = 0; b < 2; ++b)
#pragma unroll
            for (int m = 0; m < 4; ++m)
#pragma unroll
                for (int n = 0; n < 2; ++n) acc[a][b][m][n] = (f32x4){0.f, 0.f, 0.f, 0.f};
    bf16x8 At[4][2], B0[2][2], B1[2][2];
    const char* gA = (const char*)g.A; const char* cB = (const char*)g.Bt + (size_t)cur.pn * tstep;
    unsigned curA[2][2], nxtA[2][2];
#define PG8_GA_ROWS(dst, u_) do { _Pragma("unroll") for (int i_ = 0; i_ < 2; ++i_) { unsigned o_[2]; S.rows(u_, RA_[i_], o_); dst[0][i_] = o_[0] + CA2_[i_]; dst[1][i_] = o_[1] + CA2_[i_]; } } while (0)
    PG8_GA_ROWS(curA, cur);
    S.a_ready(cur);
    PG8_STAGE(PG8_SB(0, 0), cB, voffB); PG8_STAGE(PG8_SA(0, 0), gA, curA[0]); PG8_STAGE(PG8_SB(0, 1), cB + hstep, voffB); PG8_STAGE(PG8_SA(0, 1), gA, curA[1]);
    if (wr == 1) PG8_BAR;
    PG8_WAIT_V(4); PG8_BAR;
    PG8_STAGE(PG8_SB(1, 0), cB + kstep, voffB); PG8_STAGE(PG8_SA(1, 0), gA + kstep, curA[0]); PG8_STAGE(PG8_SB(1, 1), cB + hstep + kstep, voffB);
    PG8_WAIT_V(6); PG8_BAR;
    PG8_STAMP();
    for (;;) {
        const bool has_next = S.next(ui + 1, nxt);
        if constexpr (Epi::HAS_PRE) E.pre(cur, wr, wc, fr, fq);
        const char* nB = has_next ? (const char*)g.Bt + (size_t)nxt.pn * tstep : cB;
        if (has_next) PG8_GA_ROWS(nxtA, nxt); else { nxtA[0][0] = curA[0][0]; nxtA[0][1] = curA[0][1]; nxtA[1][0] = curA[1][0]; nxtA[1][1] = curA[1][1]; }
        for (int t = 0; t < nt; t += 2) {
            const bool last = (t == nt - 2);
            const char* a1 = gA + (size_t)(t + 1) * kstep;
            const char* a2 = last ? gA : gA + (size_t)(t + 2) * kstep; const char* b2 = last ? nB : cB + (size_t)(t + 2) * kstep;
            const unsigned s0_[2] = {last ? nxtA[0][0] : curA[0][0], last ? nxtA[0][1] : curA[0][1]}, s1_[2] = {last ? nxtA[1][0] : curA[1][0], last ? nxtA[1][1] : curA[1][1]};
            const char* a3 = a2 + kstep; const char* b3 = b2 + kstep;
            if (last && has_next) S.a_ready(nxt);
            PG8_LDB(B0, 0, 0); PG8_SCHED; PG8_LDA(At, 0, 0); PG8_STAGE(PG8_SA(1, 1), a1, curA[1]);
            PG8_WAIT_L(8); PG8_BAR; PG8_WAIT_L(0); PG8_MMA(0, 0, At, B0); PG8_BAR; PG8_SCHED;
            PG8_LDB(B1, 0, 1); PG8_STAGE(PG8_SB(0, 0), b2, voffB);
            PG8_BAR; PG8_WAIT_L(0); PG8_MMA(0, 1, At, B1); PG8_BAR;
            PG8_LDA(At, 0, 1); PG8_STAGE(PG8_SA(0, 0), a2, s0_);
            PG8_BAR; PG8_WAIT_L(0); PG8_MMA(1, 0, At, B0); PG8_BAR; PG8_SCHED;
            PG8_STAGE(PG8_SB(0, 1), b2 + hstep, voffB);
            PG8_WAIT_V(6); PG8_BAR; PG8_MMA(1, 1, At, B1); PG8_BAR;
            PG8_LDB(B0, 1, 0); PG8_SCHED; PG8_LDA(At, 1, 0); PG8_STAGE(PG8_SA(0, 1), a2, s1_);
            PG8_WAIT_L(8); PG8_BAR; PG8_WAIT_L(0); PG8_MMA(0, 0, At, B0); PG8_BAR; PG8_SCHED;
            PG8_LDB(B1, 1, 1); PG8_STAGE(PG8_SB(1, 0), b3, voffB);
            PG8_BAR; PG8_WAIT_L(0); PG8_MMA(0, 1, At, B1); PG8_BAR;
            PG8_LDA(At, 1, 1); PG8_STAGE(PG8_SA(1, 0), a3, s0_);
            PG8_BAR; PG8_WAIT_L(0); PG8_MMA(1, 0, At, B0); PG8_BAR; PG8_SCHED;
            PG8_STAGE(PG8_SB(1, 1), b3 + hstep, voffB);
            PG8_WAIT_V(6); PG8_BAR; PG8_MMA(1, 1, At, B1); PG8_BAR;
        }
        PG8_STAMP();
        if constexpr (!Epi::AFTER_DRAIN) { E(acc, cur, wr, wc, fr, fq); S.done(cur); }
        PG8_STAMP();
        if (!has_next) break;
#pragma unroll
        for (int a = 0; a < 2; ++a)
#pragma unroll
            for (int b = 0; b < 2; ++b)
#pragma unroll
                for (int m = 0; m < 4; ++m)
#pragma unroll
                    for (int n = 0; n < 2; ++n) acc[a][b][m][n] = (f32x4){0.f, 0.f, 0.f, 0.f};
        cur = nxt; cB = nB; ++ui; curA[0][0] = nxtA[0][0]; curA[0][1] = nxtA[0][1]; curA[1][0] = nxtA[1][0]; curA[1][1] = nxtA[1][1];
    }
    PG8_WAIT_V(0);
    if (wr == 0) PG8_BAR;
    PG8_BAR;
    if constexpr (Epi::AFTER_DRAIN) { E.fused(acc, cur, wr, wc, fr, fq, lds, wid, lane); S.done(cur); }
    PG8_STAMP();
    if (STAMP && wid == 0) { stamps[lane] = lane < nts ? (((unsigned long long)(unsigned)ts_hi << 32) | (unsigned)ts_lo) : 0ull;
        if (lane == 62) stamps[62] = rt_entry; if (lane == 63) stamps[63] = (unsigned long long)wall_clock64(); }
#undef PG8_STAMP
#undef PG8_GA_ROWS
#undef PG8_SA
#undef PG8_SB
#undef PG8_STAGE
#undef PG8_LDA
#undef PG8_LDB
#undef PG8_MMA
#undef PG8_WAIT_V
#undef PG8_WAIT_L
#undef PG8_BAR
#undef PG8_SCHED
}
}
#define XB_TMO      128
#define XB_XCNT(j)  (256  + 64 * (j))
#define XB_XSUB(j)  (1280 + 64 * (j))
#define XB_XGEN(j)  (2304 + 64 * (j))
#define XB_TOP      3328
#define XB_TOPGEN   3392
#define XCD_BAR_WORDS 3456
#define XB_SPIN_CAP (1u << 18)
#define LAS __attribute__((address_space(3)))

__device__ __forceinline__ unsigned xb_ld(unsigned* p)              { return __hip_atomic_load(p, __ATOMIC_RELAXED, __HIP_MEMORY_SCOPE_AGENT); }
__device__ __forceinline__ unsigned xb_add(unsigned* p, unsigned v) { return __hip_atomic_fetch_add(p, v, __ATOMIC_RELAXED, __HIP_MEMORY_SCOPE_AGENT); }
__device__ __forceinline__ unsigned xb_xcc_id() { return (unsigned)__builtin_amdgcn_s_getreg((3 << 11) | 20) & 0xFu; }
#define XB_SPIN(cond, bar) do { unsigned _sp = 0; while (cond) { __builtin_amdgcn_s_sleep(1); \
    if ((++_sp & 255u) == 0u) { if (xb_ld(&(bar)[XB_TMO])) break; if (_sp > XB_SPIN_CAP) { atomicAdd(&(bar)[XB_TMO], 1u); break; } } } } while (0)

struct XcdBarrier {
    unsigned* bar; unsigned x;
    volatile LAS unsigned* st;
};

__device__ __forceinline__ XcdBarrier xcd_barrier_post(unsigned* bar, volatile LAS unsigned* st) {
    XcdBarrier b; b.bar = bar; b.x = xb_xcc_id(); b.st = st;
    if (threadIdx.x == 0) (void)xb_add(&bar[XB_XCNT(b.x)], 1u);
    return b;
}
__device__ __forceinline__ void xcd_barrier_complete(unsigned* bar, unsigned x, unsigned& nloc, unsigned& nx) {
    const unsigned G = gridDim.x * gridDim.y * gridDim.z;
    unsigned sum, cnt, mine, sp = 0u;
    for (;;) {
        sum = 0u; cnt = 0u; mine = 0u;
#pragma unroll
        for (unsigned j = 0; j < 16; ++j) { const unsigned c = xb_ld(&bar[XB_XCNT(j)]); sum += c; cnt += (c > 0u) ? 1u : 0u; mine = (j == x) ? c : mine; }
        if (sum == G) break;
        __builtin_amdgcn_s_sleep(1);
        if ((++sp & 255u) == 0u) { if (xb_ld(&bar[XB_TMO])) break; if (sp > XB_SPIN_CAP) { atomicAdd(&bar[XB_TMO], 1u); break; } }
    }
    nloc = mine > 0u ? mine : 1u; nx = cnt > 0u ? cnt : 1u;
}

__device__ __forceinline__ void xcd_barrier(const XcdBarrier& b) {
    asm volatile("s_waitcnt vmcnt(0)" ::: "memory");
    __syncthreads();
    if (threadIdx.x == 0) {
        unsigned* bar = b.bar;
        __builtin_amdgcn_s_waitcnt(0);
        unsigned nloc = b.st[0], nx = b.st[1];
        if (nloc == 0u) { xcd_barrier_complete(bar, b.x, nloc, nx); b.st[0] = nloc; b.st[1] = nx; }
        const unsigned old = xb_add(&bar[XB_XSUB(b.x)], 1u);
        const unsigned gen = old / nloc;
        if (old + 1u == (gen + 1u) * nloc) {
            __builtin_amdgcn_fence(__ATOMIC_RELEASE, "agent");
            asm volatile("s_waitcnt vmcnt(0)" ::: "memory");
            const unsigned og = xb_add(&bar[XB_TOP], 1u);
            const unsigned tg = og / nx;
            if (og + 1u == (tg + 1u) * nx) xb_add(&bar[XB_TOPGEN], 1u);
            else XB_SPIN(xb_ld(&bar[XB_TOPGEN]) == tg, bar);
            __builtin_amdgcn_fence(__ATOMIC_ACQUIRE, "agent");
            xb_add(&bar[XB_XGEN(b.x)], 1u);
            asm volatile("s_waitcnt vmcnt(0)" ::: "memory");
        } else {
            XB_SPIN(xb_ld(&bar[XB_XGEN(b.x)]) == gen, bar);
            __builtin_amdgcn_fence(__ATOMIC_ACQUIRE, "agent");
            asm volatile("s_waitcnt vmcnt(0)" ::: "memory");
        }
    }
    __syncthreads();
}

typedef unsigned short bf16_t;
typedef float f32x4 __attribute__((ext_vector_type(4)));
typedef float f32x2v __attribute__((ext_vector_type(2)));
typedef unsigned u32x4 __attribute__((ext_vector_type(4)));
typedef unsigned u32x2 __attribute__((ext_vector_type(2)));

constexpr int D = 1024, NB = 2, SEQ = 16384, NCTX = 256;
constexpr int NL = NB * SEQ;
constexpr int NCT = NB * NCTX;
constexpr int TALL = NL + NCT;
constexpr int NH = 8, DK = 128;
constexpr int QKVC = 3072, GIN = 4128, GINP = 4352;
constexpr int NE = 32, DFF = 1024;
constexpr int MAXROWS = NL * 4 + NE * 256;
constexpr int NTHR = 512;
constexpr int LDS_BYTES = 160 * 1024;
constexpr int LDS_MISC = 128 * 1024;

constexpr size_t AL(size_t x) { return (x + 255) & ~(size_t)255; }
constexpr size_t WS_CTL   = 0;                               constexpr size_t CTL_BYTES = 65536;
constexpr size_t CTL_CNT  = 16384;
constexpr size_t CTL_SCANQ = 20480;
constexpr size_t CTL_PREPQ = 24576;
constexpr size_t CTL_CVTQ  = 28672;
constexpr size_t WS_MOD   = WS_CTL + CTL_BYTES;
constexpr size_t WS_POSR  = AL(WS_MOD + 2 * 3 * 6144 * 4);
constexpr size_t WS_POSC  = AL(WS_POSR + 256 * 512 * 4);
constexpr size_t WS_TILEE = AL(WS_POSC + 64 * 512 * 4);
constexpr size_t WS_FT    = AL(WS_TILEE + 2 * 1024 * 4);
constexpr size_t WS_TW    = AL(WS_FT + 65536);
constexpr size_t WS_WRT   = AL(WS_TW + 131072);
constexpr size_t WS_BTIN  = AL(WS_WRT + 262144);
constexpr size_t WS_BTOUT = AL(WS_BTIN + (size_t)GINP * 1024 * 2);
constexpr size_t WS_BTFN  = AL(WS_BTOUT + (size_t)1024 * 1024 * 2);
constexpr size_t WS_BTGU  = AL(WS_BTFN + (size_t)1024 * 2048 * 2);
constexpr size_t WS_BTDN  = AL(WS_BTGU + (size_t)2 * 32 * 2048 * 1024 * 2);
constexpr size_t WS_X0    = AL(WS_BTDN + (size_t)2 * 32 * 1024 * 1024 * 2);
constexpr size_t WS_HB    = AL(WS_X0 + (size_t)NL * 1024 * 4);
constexpr size_t WS_TOPE  = AL(WS_HB + (size_t)TALL * 1024 * 2);
constexpr size_t WS_TOPW  = AL(WS_TOPE + (size_t)NL * 16);
constexpr size_t WS_SLOT  = AL(WS_TOPW + (size_t)NL * 16);
constexpr size_t WS_POS   = AL(WS_SLOT + (size_t)NL * 16);
constexpr size_t WS_ROWTOK = AL(WS_POS + (size_t)NL * 16);
constexpr size_t WS_SCR   = AL(WS_ROWTOK + (size_t)NE * NL * 4);
constexpr size_t WS_PROJ  = WS_SCR;
constexpr size_t WS_GATES = AL(WS_PROJ + (size_t)TALL * 4096 * 2);
constexpr size_t SCN_BLK  = 98304;
constexpr size_t WS_SCN   = AL(WS_GATES + (size_t)TALL * 32 * 4);
constexpr size_t WS_DEC   = AL(WS_SCN + (size_t)8320 * SCN_BLK);
constexpr size_t WS_ODUMP = AL(WS_DEC + 8320 * 4);
constexpr size_t WS_SSAVE = AL(WS_ODUMP + 4096);
constexpr size_t WS_OF    = AL(WS_SSAVE + (size_t)64 * 8 * 64 * 32 * 4);
constexpr size_t WS_OB    = AL(WS_OF + (size_t)NL * 1024 * 2);
constexpr size_t WS_QKVC  = AL(WS_OB + (size_t)NL * 1024 * 2);
constexpr size_t WS_GDN_END = AL(WS_QKVC + (size_t)16 * 260 * 3 * 8192 * 2);
constexpr size_t WS_XS    = WS_SCR;
constexpr size_t WS_ACT   = AL(WS_XS + (size_t)MAXROWS * 1024 * 2);
constexpr size_t WS_MOE_END = AL(WS_ACT + (size_t)MAXROWS * 1024 * 2);
constexpr size_t WS_YR    = WS_SCR;
constexpr size_t WS_YI    = AL(WS_YR + (size_t)NL * 1024 * 2);
constexpr size_t WS_XCAT  = AL(WS_YI + (size_t)NL * 1024 * 2);
constexpr size_t WS_FN_END = AL(WS_XCAT + (size_t)NL * 2048 * 2);
constexpr size_t WS_END = WS_GDN_END > WS_MOE_END ? (WS_GDN_END > WS_FN_END ? WS_GDN_END : WS_FN_END) : (WS_MOE_END > WS_FN_END ? WS_MOE_END : WS_FN_END);

struct Args {
    const float* x; const float* c; const float* ctx; const float* c_ctx; const float* w_ada; const float* b_ada; const float* g_mix; const float* g_ffn;
    const float* gdn_w_in; const float* gdn_conv; const float* gdn_a_log; const float* gdn_dt_bias; const float* gdn_onorm; const float* gdn_w_out; const float* fnet_w_out;
    const float* moe_w_router; const float* moe_b_router; const float* moe_w_gu; const float* moe_b_gu; const float* moe_w_down; const float* moe_b_down; const float* g_final;
    float* out; unsigned char* ws; int ph_lo, ph_hi;
};

__device__ __forceinline__ unsigned short f2bf(float f) { unsigned u = __float_as_uint(f); u += 0x7fffu + ((u >> 16) & 1u); return (unsigned short)(u >> 16); }
__device__ __forceinline__ float bf2f(unsigned short h) { return __uint_as_float((unsigned)h << 16); }
__device__ __forceinline__ unsigned pack2(float a, float b) { return (unsigned)f2bf(a) | ((unsigned)f2bf(b) << 16); }
__device__ __forceinline__ float bflo(unsigned w) { return __uint_as_float(w << 16); }
__device__ __forceinline__ float bfhi(unsigned w) { return __uint_as_float(w & 0xffff0000u); }
__device__ __forceinline__ float wave_sum(float v) {
#pragma unroll
    for (int o = 32; o >= 1; o >>= 1) v += __shfl_xor(v, o);
    return v;
}
__device__ __forceinline__ float silu_f(float x) { return x * __builtin_amdgcn_rcpf(1.f + __expf(-x)); }
__device__ __forceinline__ float sigmoid_f(float x) { return 1.f / (1.f + __expf(-x)); }

struct EpiProj {
    static constexpr bool PERM = true, AFTER_DRAIN = false, HAS_PRE = false;
    bf16_t* P; float* Gt;
    __device__ __forceinline__ void operator()(const f32x4 (&acc)[2][2][4][2], const pg8::Unit& u, int wr, int wc, int fr, int fq) const {
        const int row0 = u.pm * 256 + wr * 64 + fr;
        if (u.pn < 16) {
            const int col0 = u.pn * 256 + wc * 32 + 8 * fq;
#pragma unroll
            for (int ai = 0; ai < 2; ++ai)
#pragma unroll
                for (int m = 0; m < 4; ++m) { bf16_t* rowp = P + (size_t)(row0 + ai * 128 + m * 16) * 4096 + col0;
#pragma unroll
                    for (int bj = 0; bj < 2; ++bj) { const f32x4 v0 = acc[ai][bj][m][0], v1 = acc[ai][bj][m][1];
                        u32x4 w; w.x = pg8::cvt_pk_bf16(v0[0], v0[1]); w.y = pg8::cvt_pk_bf16(v0[2], v0[3]); w.z = pg8::cvt_pk_bf16(v1[0], v1[1]); w.w = pg8::cvt_pk_bf16(v1[2], v1[3]);
                        *(u32x4*)(rowp + bj * 128) = w; } }
        } else if (wc == 0) {
#pragma unroll
            for (int ai = 0; ai < 2; ++ai)
#pragma unroll
                for (int m = 0; m < 4; ++m) { float* gp = Gt + (size_t)(row0 + ai * 128 + m * 16) * 32 + 8 * fq;
                    *(f32x4*)gp = acc[ai][0][m][0]; *(f32x4*)(gp + 4) = acc[ai][0][m][1]; }
        }
    }
};
struct EpiResid {
    static constexpr bool PERM = false, AFTER_DRAIN = false, HAS_PRE = false;
    float* X; const float* gate;
    __device__ __forceinline__ void operator()(const f32x4 (&acc)[2][2][4][2], const pg8::Unit& u, int wr, int wc, int fr, int fq) const {
        const int row0 = u.pm * 256 + wr * 64 + fr, col0 = u.pn * 256 + wc * 32 + 4 * fq;
        const float* gp = gate + (size_t)((u.pm * 256) >> 14) * 6144 + col0;
        f32x4 gv[2][2];
#pragma unroll
        for (int bj = 0; bj < 2; ++bj)
#pragma unroll
            for (int n = 0; n < 2; ++n) gv[bj][n] = *(const f32x4*)(gp + bj * 128 + n * 16);
#pragma unroll
        for (int ai = 0; ai < 2; ++ai)
#pragma unroll
            for (int m = 0; m < 4; ++m) { float* xp = X + (size_t)(row0 + ai * 128 + m * 16) * 1024 + col0; f32x4 xv[2][2];
#pragma unroll
                for (int bj = 0; bj < 2; ++bj)
#pragma unroll
                    for (int n = 0; n < 2; ++n) xv[bj][n] = *(const f32x4*)(xp + bj * 128 + n * 16);
                asm volatile("" ::: "memory");
#pragma unroll
                for (int bj = 0; bj < 2; ++bj)
#pragma unroll
                    for (int n = 0; n < 2; ++n) *(f32x4*)(xp + bj * 128 + n * 16) = xv[bj][n] + gv[bj][n] * acc[ai][bj][m][n]; }
    }
};
struct EpiResid0 {
    static constexpr bool PERM = false, AFTER_DRAIN = false, HAS_PRE = false;
    float* X; const float* xin; const float* posr; const float* posc; const float* gate;
    __device__ __forceinline__ void operator()(const f32x4 (&acc)[2][2][4][2], const pg8::Unit& u, int wr, int wc, int fr, int fq) const {
        const int row0 = u.pm * 256 + wr * 64 + fr, col0 = u.pn * 256 + wc * 32 + 4 * fq;
        const float* gp = gate + (size_t)((u.pm * 256) >> 14) * 6144 + col0;
        f32x4 gv[2][2];
#pragma unroll
        for (int bj = 0; bj < 2; ++bj)
#pragma unroll
            for (int n = 0; n < 2; ++n) gv[bj][n] = *(const f32x4*)(gp + bj * 128 + n * 16);
#pragma unroll
        for (int ai = 0; ai < 2; ++ai)
#pragma unroll
            for (int m = 0; m < 4; ++m) { const int r = row0 + ai * 128 + m * 16; const int tt = r & 16383; const size_t ro = (size_t)r * 1024 + col0;
                const float* pp = (col0 < 512) ? posr + (size_t)(tt >> 6) * 512 + col0 : posc + (size_t)(tt & 63) * 512 + (col0 - 512);
                f32x4 xv[2][2], pv[2][2];
#pragma unroll
                for (int bj = 0; bj < 2; ++bj)
#pragma unroll
                    for (int n = 0; n < 2; ++n) { xv[bj][n] = __builtin_nontemporal_load((const f32x4*)(xin + ro + bj * 128 + n * 16)); pv[bj][n] = *(const f32x4*)(pp + bj * 128 + n * 16); }
                asm volatile("" ::: "memory");
#pragma unroll
                for (int bj = 0; bj < 2; ++bj)
#pragma unroll
                    for (int n = 0; n < 2; ++n) *(f32x4*)(X + ro + bj * 128 + n * 16) = xv[bj][n] + pv[bj][n] + gv[bj][n] * acc[ai][bj][m][n]; }
    }
};
struct EpiGLU {
    static constexpr bool PERM = true, AFTER_DRAIN = false, HAS_PRE = true;
    bf16_t* ACT; const float* bgu;
    mutable f32x4 pb0, pb1, pb2, pb3;
    __device__ __forceinline__ void pre(const pg8::Unit& u, int wr, int wc, int fr, int fq) const { const float* bp = bgu + (size_t)(u.pn >> 3) * 2048 + 2 * ((u.pn & 7) * 128 + wc * 32 + 8 * fq);
        pb0 = *(const f32x4*)(bp); pb1 = *(const f32x4*)(bp + 4); pb2 = *(const f32x4*)(bp + 8); pb3 = *(const f32x4*)(bp + 12); }
    __device__ __forceinline__ void operator()(const f32x4 (&acc)[2][2][4][2], const pg8::Unit& u, int wr, int wc, int fr, int fq) const {
        const int e = u.pn >> 3, ct = u.pn & 7; const int row0 = u.pm * 256 + wr * 64 + fr; const int j0 = ct * 128 + wc * 32 + 8 * fq;
        const f32x4 b0 = pb0, b1 = pb1, b2 = pb2, b3 = pb3; (void)e;
        const float bg[8] = {b0[0], b0[2], b1[0], b1[2], b2[0], b2[2], b3[0], b3[2]}, bu[8] = {b0[1], b0[3], b1[1], b1[3], b2[1], b2[3], b3[1], b3[3]};
#pragma unroll
        for (int ai = 0; ai < 2; ++ai)
#pragma unroll
            for (int m = 0; m < 4; ++m) { float a[8];
#pragma unroll
                for (int n = 0; n < 2; ++n)
#pragma unroll
                    for (int i = 0; i < 4; ++i) { float gt = acc[ai][0][m][n][i] + bg[n * 4 + i], up = acc[ai][1][m][n][i] + bu[n * 4 + i];
                        gt = fminf(gt, 7.0f); up = fminf(fmaxf(up, -7.0f), 7.0f);
                        const float glu = gt * __builtin_amdgcn_rcpf(1.f + __expf(-1.702f * gt)); a[n * 4 + i] = (up + 1.f) * glu; }
                u32x4 w; w.x = pg8::cvt_pk_bf16(a[0], a[1]); w.y = pg8::cvt_pk_bf16(a[2], a[3]); w.z = pg8::cvt_pk_bf16(a[4], a[5]); w.w = pg8::cvt_pk_bf16(a[6], a[7]);
                *(u32x4*)(ACT + (size_t)(row0 + ai * 128 + m * 16) * 1024 + j0) = w; }
    }
};
struct EpiDown {
    static constexpr bool PERM = true, AFTER_DRAIN = false, HAS_PRE = true;
    bf16_t* YS; const float* bdn;
    mutable f32x4 pbv[2][2];
    __device__ __forceinline__ void pre(const pg8::Unit& u, int wr, int wc, int fr, int fq) const { const float* bp = bdn + (size_t)(u.pn >> 2) * 1024 + (u.pn & 3) * 256 + wc * 32 + 8 * fq;
#pragma unroll
        for (int bj = 0; bj < 2; ++bj)
#pragma unroll
            for (int n = 0; n < 2; ++n) pbv[bj][n] = *(const f32x4*)(bp + bj * 128 + 4 * n); }
    __device__ __forceinline__ void operator()(const f32x4 (&acc)[2][2][4][2], const pg8::Unit& u, int wr, int wc, int fr, int fq) const {
        const int e = u.pn >> 2, ct = u.pn & 3; const int row0 = u.pm * 256 + wr * 64 + fr; const int col0 = ct * 256 + wc * 32 + 8 * fq;
        f32x4 bv[2][2]; (void)e;
#pragma unroll
        for (int bj = 0; bj < 2; ++bj)
#pragma unroll
            for (int n = 0; n < 2; ++n) bv[bj][n] = pbv[bj][n];
#pragma unroll
        for (int ai = 0; ai < 2; ++ai)
#pragma unroll
            for (int m = 0; m < 4; ++m) { bf16_t* rowp = YS + (size_t)(row0 + ai * 128 + m * 16) * 1024 + col0;
#pragma unroll
                for (int bj = 0; bj < 2; ++bj) { const f32x4 v0 = acc[ai][bj][m][0] + bv[bj][0], v1 = acc[ai][bj][m][1] + bv[bj][1];
                    u32x4 w; w.x = pg8::cvt_pk_bf16(v0[0], v0[1]); w.y = pg8::cvt_pk_bf16(v0[2], v0[3]); w.z = pg8::cvt_pk_bf16(v1[0], v1[1]); w.w = pg8::cvt_pk_bf16(v1[2], v1[3]);
                    *(u32x4*)(rowp + bj * 128) = w; } }
    }
};
constexpr int MT_OFF = 131072;
struct MoeTab { int rb[32]; int cn[32]; int tb[33]; int nt; int te[560]; int nb; int be[224]; int bt0[224]; int bn[224]; };
__device__ __forceinline__ void moe_build_tables(const int* CNT, unsigned char* lds) {
    MoeTab* T = (MoeTab*)(lds + MT_OFF); const int t = threadIdx.x;
    __syncthreads();
    if (t < 64) { const int e = t & 31; const int c = CNT[e]; const int nt = (c + 255) >> 8; int inc = nt;
#pragma unroll
        for (int o = 1; o < 32; o <<= 1) { const int v = __shfl_up(inc, o, 32); if (e >= o) inc += v; }
        if (t < 32) { T->rb[e] = (inc - nt) * 256; T->cn[e] = c; T->tb[e] = inc - nt; if (e == 31) { T->tb[32] = inc; T->nt = inc; T->nb = 0; } } }
    __syncthreads();
    for (int rt = t; rt < T->nt; rt += NTHR) { int e = 0;
#pragma unroll
        for (int q = 1; q < 32; ++q) e += (T->tb[q] <= rt) ? 1 : 0;
        T->te[rt] = e; }
    __syncthreads();
}
constexpr int RT_OFF = MT_OFF + 8192, RT_MAXU = 20;
template <class Sched> __device__ __forceinline__ void moe_build_rowtab(const Sched& S, const int* rowtok, unsigned char* lds) {
    const MoeTab* T = (const MoeTab*)(lds + MT_OFF); int* RT = (int*)(lds + RT_OFF); const int t = threadIdx.x;
    int rtv[RT_MAXU / 2]; bool rok[RT_MAXU / 2];
#pragma unroll
    for (int k = 0; k < RT_MAXU / 2; ++k) { const int i = (t >> 8) + 2 * k; pg8::Unit u; rok[k] = S.next(i, u); rtv[k] = 0;
        if (rok[k]) { const int e = u.pn / S.nN; const int r = (u.pm - T->tb[e]) * 256 + (t & 255); if (r < T->cn[e]) rtv[k] = rowtok[(size_t)e * NL + r]; } }
#pragma unroll
    for (int k = 0; k < RT_MAXU / 2; ++k) { const int i = (t >> 8) + 2 * k; if (rok[k]) RT[i * 256 + (t & 255)] = rtv[k]; }
    __syncthreads();
}
template <bool RTFAST, bool XPERM, bool REV = false> struct MoeOrderT {
    int G, c, nN; const MoeTab* T; const int* rowtab; unsigned K2; mutable int cursor;
    __device__ __forceinline__ bool next(int i, pg8::Unit& u) const {
        const int cp = (XPERM && (G & 7) == 0) ? (c & 7) * (G >> 3) + (c >> 3) : c;
        const int L = i * G + cp; const int nt = T->nt; if (L >= nt * nN) return false;
        const int rt = RTFAST ? L % nt : L / nN, ct = RTFAST ? L / nt : L % nN;
        const int rr = REV ? nt - 1 - rt : rt; u.pm = rr; u.pn = T->te[rr] * nN + ct; return true;
    }
    __device__ __forceinline__ void rows(const pg8::Unit& u, int R, unsigned (&o)[2]) const {
        const int cp = (XPERM && (G & 7) == 0) ? (c & 7) * (G >> 3) + (c >> 3) : c; const int i = ((REV ? T->nt - 1 - u.pm : u.pm) * nN + (u.pn % nN) - cp) / G; const int* r_ = rowtab + i * 256;
        o[0] = (unsigned)r_[R] * K2; o[1] = (unsigned)r_[R + 128] * K2;
    }
    __device__ __forceinline__ void a_ready(const pg8::Unit&) const {}
    __device__ __forceinline__ void done(const pg8::Unit&) const {}
};
typedef MoeOrderT<false, true> MoeOrder; typedef MoeOrderT<false, true, true> MoeOrderR;

#define LDSF(off) ((float*)(lds + (off)))

template <class RM> __device__ __forceinline__ void cvt_tile(const float* __restrict__ src, int ldsrc, int nsrc, bf16_t* __restrict__ dst, int lddst, int k0, int n0, float* tile, RM rm) {
    const int t = threadIdx.x; const int nn = t & 127, kq = t >> 7; float vin[16];
#pragma unroll
    for (int i = 0; i < 16; ++i) { const int kk = kq + 4 * i; vin[i] = (n0 + nn < nsrc) ? __builtin_nontemporal_load(src + (size_t)(k0 + kk) * ldsrc + n0 + nn) : 0.f;     }
#pragma unroll
    for (int i = 0; i < 16; ++i) { const int kk = kq + 4 * i; tile[kk * 129 + nn] = vin[i]; }
    __syncthreads();
#pragma unroll
    for (int i = 0; i < 2; ++i) { const int item = t + 512 * i; const int g8 = item & 7, n2 = item >> 3;
        if (n0 + n2 < nsrc) { float v[8];
#pragma unroll
            for (int j = 0; j < 8; ++j) v[j] = tile[(8 * g8 + j) * 129 + n2];
            u32x4 w; w.x = pack2(v[0], v[1]); w.y = pack2(v[2], v[3]); w.z = pack2(v[4], v[5]); w.w = pack2(v[6], v[7]);
            *(u32x4*)(dst + (size_t)rm(n0 + n2) * lddst + k0 + 8 * g8) = w; } }
    __syncthreads();
}
struct RMId { __device__ __forceinline__ int operator()(int n) const { return n; } };
struct RMGu { __device__ __forceinline__ int operator()(int n) const { const int j = n >> 1; return (j >> 7) * 256 + (j & 127) + ((n & 1) << 7); } };

constexpr int MOE_CVT_UNITS = 64 * 256 + 64 * 128;
__device__ __forceinline__ void moe_cvt_unit(const Args& a, float* tile, int q) {
    unsigned char* ws = a.ws;
    if (q < 64 * 256) { const int le = q >> 8, tt = q & 255;
        cvt_tile(a.moe_w_gu + (size_t)le * 1024 * 2048, 2048, 2048, (bf16_t*)(ws + WS_BTGU) + (size_t)le * 2048 * 1024, 1024, (tt >> 4) * 64, (tt & 15) * 128, tile, RMGu());
    } else { const int q2 = q - 64 * 256; const int le = q2 >> 7, tt = q2 & 127;
        cvt_tile(a.moe_w_down + (size_t)le * 1024 * 1024, 1024, 1024, (bf16_t*)(ws + WS_BTDN) + (size_t)le * 1024 * 1024, 1024, (tt >> 3) * 64, (tt & 7) * 128, tile, RMId()); }
}

__device__ __forceinline__ void p0_prologue(const Args& a, unsigned char* lds) {
    unsigned char* ws = a.ws; const int t = threadIdx.x; const int G = gridDim.x;
    float* MOD = (float*)(ws + WS_MOD);
    constexpr int U_ADA = 2 * 192, U_POS = 448, U_WIN = 16 * 33, U_WINZ = 7, U_WOUT = 16 * 8, U_GU = 64 * 256, U_DN = 64 * 128, U_FN = 256;
    constexpr int O_POS = U_ADA, O_WIN = O_POS + U_POS, O_WINZ = O_WIN + U_WIN, O_WOUT = O_WINZ + U_WINZ, O_GU = O_WOUT + U_WOUT, O_DN = O_GU + U_GU, O_FN = O_DN + U_DN, U_ALL = O_FN + U_FN;
    float* tile = LDSF(0);
    for (int uu = blockIdx.x; uu < U_ALL - (O_FN - O_GU); uu += G) { const int u = uu >= O_GU ? uu + (O_FN - O_GU) : uu;
        if (u < O_POS) {
            const int l = u / 192, cb = u % 192; float* sv = LDSF(0);
            const int col = t & 31, kp = t >> 5; const float* wp = a.w_ada + (size_t)l * 1024 * 6144 + cb * 32 + col;
            float wv_[64]; float cv_[6];
#pragma unroll
            for (int j = 0; j < 64; ++j) wv_[j] = __builtin_nontemporal_load(wp + (size_t)(kp + 16 * j) * 6144);
#pragma unroll
            for (int j = 0; j < 6; ++j) { const int i = t + 512 * j; const int v = i >> 10, k = i & 1023; cv_[j] = v < 2 ? a.c[v * 1024 + k] : a.c_ctx[k]; }
#pragma unroll
            for (int j = 0; j < 6; ++j) sv[t + 512 * j] = silu_f(cv_[j]);
            __syncthreads();
            float s0 = 0.f, s1 = 0.f, s2 = 0.f;
#pragma unroll
            for (int j = 0; j < 64; ++j) { const int k = kp + 16 * j; const float w = wv_[j]; s0 += sv[k] * w; s1 += sv[1024 + k] * w; s2 += sv[2048 + k] * w; }
            float* red = LDSF(16384);
            red[(0 * 16 + kp) * 32 + col] = s0; red[(1 * 16 + kp) * 32 + col] = s1; red[(2 * 16 + kp) * 32 + col] = s2;
            __syncthreads();
            if (t < 96) { const int v = t >> 5, cc = t & 31; float s = 0.f; for (int k = 0; k < 16; ++k) s += red[(v * 16 + k) * 32 + cc];
                MOD[((size_t)l * 3 + v) * 6144 + cb * 32 + cc] = s + a.b_ada[l * 6144 + cb * 32 + cc]; }
            __syncthreads();
        } else if (u < O_WIN) {
            const int r = u - O_POS;
            if (r < 320) { const int p = r < 256 ? r : r - 256; float* dstp = (float*)(ws + (r < 256 ? WS_POSR : WS_POSC)) + (size_t)p * 512;
                const int i = t & 255; const double om = pow(10000.0, -(double)i / 256.0); const double ang = (double)p * om;
                dstp[t] = (float)(t < 256 ? sin(ang) : cos(ang)); }
            else if (r < 384) { bf16_t* ft = (bf16_t*)(ws + WS_FT);
                { const int i = (r - 320) * 512 + t; const int j = i & 7, ln = (i >> 3) & 63, ks = (i >> 9) & 3, mtp = (i >> 11) & 7, trig = i >> 14; const int m_ = ln & 15, g_ = ln >> 4;
                    const int n1 = 32 * ks + (j < 4 ? 4 * g_ + j : 16 + 4 * g_ + (j - 4)), k1 = 16 * mtp + m_; const double ang = 6.283185307179586476925 * (double)((k1 * n1) & 127) / 128.0;
                    ft[i] = f2bf((float)(trig ? sin(ang) : cos(ang))); } }
            else if (r < 416) { float* tw = (float*)(ws + WS_TW);
                { const int i = (r - 384) * 512 + t; const int n2 = i >> 7, k1 = i & 127; const double ang = 6.283185307179586476925 * (double)(n2 * k1) / 16384.0; *(f32x2v*)(tw + 2 * i) = (f32x2v){(float)cos(ang), (float)sin(ang)}; } }
            else { const int l = (r - 416) >> 4, q = (r - 416) & 15; bf16_t* wt = (bf16_t*)(ws + WS_WRT) + (size_t)l * 2 * 32768; const float* wr = a.moe_w_router + (size_t)l * 1024 * 32;
                float w[4];
#pragma unroll
                for (int j = 0; j < 4; ++j) { const int i = q * 2048 + t + 512 * j; const int e = i >> 10, k = i & 1023; w[j] = wr[k * 32 + e]; }
#pragma unroll
                for (int j = 0; j < 4; ++j) { const int i = q * 2048 + t + 512 * j; const bf16_t hi = f2bf(w[j]); wt[i] = hi; wt[32768 + i] = f2bf(w[j] - bf2f(hi)); } }
        } else if (u < O_WINZ) {
            const int q = u - O_WIN; cvt_tile(a.gdn_w_in, GIN, GIN, (bf16_t*)(ws + WS_BTIN), 1024, (q / 33) * 64, (q % 33) * 128, tile, RMId());
        } else if (u < O_WOUT) {
            const int q = u - O_WINZ; u32x4* p = (u32x4*)((bf16_t*)(ws + WS_BTIN) + (size_t)(GIN + q * 32) * 1024);
            for (int i = t; i < 32 * 1024 / 8; i += NTHR) p[i] = (u32x4){0u, 0u, 0u, 0u};
        } else if (u < O_GU) {
            const int q = u - O_WOUT; cvt_tile(a.gdn_w_out, 1024, 1024, (bf16_t*)(ws + WS_BTOUT), 1024, (q / 8) * 64, (q % 8) * 128, tile, RMId());
        } else if (u < O_FN) {
        } else {
            const int q = u - O_FN; const int part = q >> 7, g = (q >> 5) & 3, c0 = (q & 31) * 4; const int kb = part * 1024 + g * 256;
            float* trg = LDSF(0); float* trt = LDSF(1024);
            if (t < 256) { const double ang = 6.283185307179586476925 * (double)t / 256.0; trg[t] = (float)(part ? sin(ang) : cos(ang)); }
            __syncthreads();
#pragma unroll
            for (int j = 0; j < 2; ++j) { const int i = t + 512 * j; const int l = i >> 2, k = i & 3; trt[i] = trg[(l * (c0 + k)) & 255]; }
            __syncthreads();
            f32x2v acc[2][2][2];
#pragma unroll
            for (int jj = 0; jj < 2; ++jj)
#pragma unroll
                for (int eo = 0; eo < 2; ++eo) { acc[jj][eo][0] = (f32x2v){0.f, 0.f}; acc[jj][eo][1] = (f32x2v){0.f, 0.f}; }
            const float* wf = a.fnet_w_out + (size_t)(g * 256) * 1024;
#pragma unroll 1
            for (int l0 = 0; l0 < 256; l0 += 32) { float w0[32], w1[32];
#pragma unroll
                for (int j = 0; j < 32; ++j) { w0[j] = *(const float*)((const char*)wf + (unsigned)(((l0 + j) * 1024 + t) * 4)); w1[j] = *(const float*)((const char*)wf + (unsigned)(((l0 + j) * 1024 + t + 512) * 4)); }
#pragma unroll
                for (int j = 0; j < 32; ++j) { if ((j & 7) == 0) asm volatile("" ::: "memory"); const f32x4 ta = *(const f32x4*)(trt + (l0 + j) * 4); const f32x2v tr2[2] = {{ta[0], ta[1]}, {ta[2], ta[3]}};
#pragma unroll
                    for (int k = 0; k < 2; ++k) { acc[0][j & 1][k] += tr2[k] * w0[j]; acc[1][j & 1][k] += tr2[k] * w1[j]; } } }
            bf16_t* bt = (bf16_t*)(ws + WS_BTFN);
#pragma unroll
            for (int jj = 0; jj < 2; ++jj) { const float s = 1.0f / 2048.0f; const f32x2v e0 = acc[jj][0][0], e1 = acc[jj][0][1], o0 = acc[jj][1][0], o1 = acc[jj][1][1];
                u32x2 lo, hi; lo.x = pack2((e0[0] + o0[0]) * s, (e0[1] + o0[1]) * s); lo.y = pack2((e1[0] + o1[0]) * s, (e1[1] + o1[1]) * s);
                hi.x = pack2((e0[0] - o0[0]) * s, (e0[1] - o0[1]) * s); hi.y = pack2((e1[0] - o1[0]) * s, (e1[1] - o1[1]) * s);
                bf16_t* rowp = bt + (size_t)(t + 512 * jj) * 2048 + kb + c0; *(u32x2*)rowp = lo; *(u32x2*)(rowp + 128) = hi; }
            __syncthreads();
        }
    }
}

__device__ __forceinline__ void p1_embed(const Args& a) {
    unsigned char* ws = a.ws; const int lane = threadIdx.x & 63, wv = threadIdx.x >> 6;
    const float* MOD = (const float*)(ws + WS_MOD); const float* POSR = (const float*)(ws + WS_POSR); const float* POSC = (const float*)(ws + WS_POSC);
    float* X0 = (float*)(ws + WS_X0); bf16_t* HB = (bf16_t*)(ws + WS_HB);
    f32x4 gm[4];
#pragma unroll
    for (int i = 0; i < 4; ++i) gm[i] = *(const f32x4*)(a.g_mix + i * 256 + lane * 4);
    for (int r = blockIdx.x * 8 + wv; r < TALL; r += gridDim.x * 8) {
        f32x4 xv[4], sh[4], sc[4]; const float* mv; float ss = 0.f;
        if (r < NCT) { const float* src = a.ctx + (size_t)r * 1024; mv = MOD + 2 * 6144;
#pragma unroll
            for (int i = 0; i < 4; ++i) xv[i] = __builtin_nontemporal_load((const f32x4*)(src + i * 256 + lane * 4));
        } else { const int n = r - NCT; const int b = n >> 14, tt = n & 16383; const float* src = a.x + (size_t)n * 1024; mv = MOD + b * 6144;
            const float* pr = POSR + (size_t)(tt >> 6) * 512; const float* pc = POSC + (size_t)(tt & 63) * 512;
#pragma unroll
            for (int i = 0; i < 4; ++i) { const int c = i * 256 + lane * 4; const f32x4 pv = c < 512 ? *(const f32x4*)(pr + c) : *(const f32x4*)(pc + c - 512); xv[i] = __builtin_nontemporal_load((const f32x4*)(src + c)) + pv; }
        }
#pragma unroll
        for (int i = 0; i < 4; ++i) { const int c = i * 256 + lane * 4; sh[i] = *(const f32x4*)(mv + c); sc[i] = *(const f32x4*)(mv + 1024 + c); }
#pragma unroll
        for (int i = 0; i < 4; ++i) ss += xv[i][0] * xv[i][0] + xv[i][1] * xv[i][1] + xv[i][2] * xv[i][2] + xv[i][3] * xv[i][3];
        ss = wave_sum(ss); const float rstd = rsqrtf(ss * (1.0f / 1024.0f) + 1e-6f);
#pragma unroll
        for (int i = 0; i < 4; ++i) { const int c = i * 256 + lane * 4;
            const f32x4 hv = xv[i] * rstd * gm[i] * (sc[i] + 1.0f) + sh[i]; u32x2 w; w.x = pack2(hv[0], hv[1]); w.y = pack2(hv[2], hv[3]); *(u32x2*)(HB + (size_t)r * 1024 + c) = w; }
    }
}

typedef short bf16x8 __attribute__((ext_vector_type(8)));
typedef unsigned long long u64_t;
#define MFMA16(A, B, C) __builtin_amdgcn_mfma_f32_16x16x32_bf16((A), (B), (C), 0, 0, 0)
__device__ __forceinline__ bf16x8 mk_frag(u64_t lo, u64_t hi) { union { u64_t q[2]; bf16x8 v; } x; x.q[0] = lo; x.q[1] = hi; return x.v; }
__device__ __forceinline__ u64_t pack4(const f32x4 v) { return (u64_t)pg8::cvt_pk_bf16(v[0], v[1]) | ((u64_t)pg8::cvt_pk_bf16(v[2], v[3]) << 32); }
__device__ __forceinline__ void raw_barrier() { asm volatile("s_waitcnt lgkmcnt(0)" ::: "memory"); __builtin_amdgcn_s_barrier(); asm volatile("" ::: "memory"); }

constexpr int PL_RAW = 0;
constexpr int PL_AN = 0;
constexpr int PL_ATT = 9216;
constexpr int PL_A32 = 18432;
constexpr int PL_TINV = 22592;
constexpr int PL_Q = 55488;
constexpr int PL_K = PL_Q + 17408;
constexpr int PL_V = PL_K + 17408;
constexpr int PL_KT = PL_V + 17408;
constexpr int PL_SC = PL_KT + 18432;
constexpr int PL_CW = PL_SC + 1024;
static_assert(PL_CW + 7680 <= LDS_BYTES - 16, "prep LDS");

__device__ __forceinline__ void chain_step_rows(int chain, int step, int& r0, int& lo, int& hi) {
    const int b = chain >> 4, dir = chain & 1;
    if (step < 4) { const int ci = dir ? 3 - step : step; lo = b * NCTX; hi = lo + NCTX; r0 = lo + 64 * ci; }
    else { const int ci = dir ? 255 - (step - 4) : step - 4; lo = NCT + b * SEQ; hi = lo + SEQ; r0 = lo + 64 * ci; }
}

template <int MODE>
__device__ __forceinline__ void prep_unit(const Args& a, unsigned char* lds, const int u, int& cwh) {
    unsigned char* ws = a.ws; const int t = threadIdx.x, lane = t & 63, wv = t >> 6; const int m = lane & 15, g = lane >> 4;
    const bf16_t* PROJ = (const bf16_t*)(ws + WS_PROJ); const float* GATES = (const float*)(ws + WS_GATES); float* DEC = (float*)(ws + WS_DEC);
    float* sc_beta = LDSF(PL_SC), * sc_gc = sc_beta + 64, * sc_egc = sc_beta + 128, * sc_ekd = sc_beta + 192; float* cw = LDSF(PL_CW);
    {
        const int step = u >> 5, chain = u & 31; const int h = (chain >> 1) & 7, dir = chain & 1; int r0, slo, shi; chain_step_rows(chain, step, r0, slo, shi);
        unsigned char* blk = ws + WS_SCN + (size_t)u * SCN_BLK;
        int tl = t; asm volatile("" : "+v"(tl));
        float gb = 0.f, ga = 0.f, dtb = 0.f, alg = 0.f;
        if (wv == 0) { const int row = r0 + (dir ? 63 - lane : lane); gb = GATES[(size_t)row * 32 + dir * 8 + h]; ga = GATES[(size_t)row * 32 + 16 + dir * 8 + h]; dtb = a.gdn_dt_bias[dir * 8 + h]; alg = a.gdn_a_log[dir * 8 + h]; }
        const int sc_ = dir ? (step < 4 ? 3 - step : 263 - step) : step; bf16_t* qc = (bf16_t*)(ws + WS_QKVC) + (size_t)(((chain >> 4) * 8 + h) * 260 + sc_) * 3 * 8192;
        u32x4 rv[MODE == 0 ? 7 : 6]; float cwv[4];
        if (MODE == 0) {
#pragma unroll
            for (int j = 0; j < 7; ++j) { const int p = tl + 512 * j; const int pq = p < 68 * 48 ? p : 68 * 48 - 1; const int rowl = pq / 48, rem = pq % 48; const int seg = rem >> 4, pc = rem & 15; const int row = r0 - 2 + rowl;
                const int rowc = row < slo ? slo : row >= shi ? shi - 1 : row; const u32x4 v = __builtin_nontemporal_load((const u32x4*)(PROJ + (size_t)rowc * 4096 + seg * 1024 + h * 128 + pc * 8));
                rv[j] = (row >= slo && row < shi) ? v : (u32x4){0u, 0u, 0u, 0u}; }
            if (cwh != h) {
#pragma unroll
                for (int j = 0; j < 4; ++j) { const int i = tl + 512 * j; const int iq = i < 1920 ? i : 1919; const int seg = iq / 640, rem = iq % 640; const int jj = rem >> 7, c = rem & 127; cwv[j] = a.gdn_conv[jj * 3072 + seg * 1024 + h * 128 + c]; } }
        } else {
#pragma unroll
            for (int j = 0; j < 6; ++j) { const int p = tl + 512 * j; const int seg = p >> 10, rowv = (p >> 4) & 63, pc = p & 15; const int ol = dir ? 63 - rowv : rowv; rv[j] = __builtin_nontemporal_load((const u32x4*)(qc + (seg * 64 + ol) * 128 + pc * 8)); }
        }
        asm volatile("" : "+v"(gb), "+v"(ga), "+v"(dtb), "+v"(alg));
        if (wv == 0) {
            const float xx = ga + dtb; const float sp = xx > 20.f ? xx : log1pf(expf(xx));
            const float gv = -expf(alg) * sp; float gc = gv;
#pragma unroll
            for (int o = 1; o < 64; o <<= 1) { const float v = __shfl_up(gc, o); if (lane >= o) gc += v; }
            const float gl = __shfl(gc, 63);
            sc_beta[lane] = 1.f / (1.f + expf(-gb)); sc_gc[lane] = gc; sc_egc[lane] = expf(gc); sc_ekd[lane] = expf(gl - gc);
            if (lane == 0) DEC[chain * 260 + step] = expf(gl); }
        if (MODE == 0) {
            if (cwh != h) {
#pragma unroll
                for (int j = 0; j < 4; ++j) { const int i = tl + 512 * j; if (i < 1920) cw[i] = cwv[j]; }
                cwh = h; }
#pragma unroll
            for (int j = 0; j < 7; ++j) { const int p = tl + 512 * j; const int rowl = p / 48, rem = p % 48; const int seg = rem >> 4, pc = rem & 15;
                if (p < 68 * 48) *(u32x4*)(lds + PL_RAW + ((seg * 68 + rowl) * 136 + pc * 8) * 2) = rv[j]; }
        } else {
#pragma unroll
            for (int j = 0; j < 6; ++j) { const int p = tl + 512 * j; const int seg = p >> 10, rowv = (p >> 4) & 63, pc = p & 15;
                *(u32x4*)(lds + (seg == 0 ? PL_Q : seg == 1 ? PL_K : PL_V) + (rowv * 136 + pc * 8) * 2) = rv[j]; }
        }
        raw_barrier();
        if (MODE == 1) { const int rowv = t >> 3, p = t & 7; const unsigned char* kp = lds + PL_K + (rowv * 136 + 16 * p) * 2; const u32x4 k0 = *(const u32x4*)kp, k1 = *(const u32x4*)(kp + 16);
            const float ek = sc_ekd[rowv]; bf16_t* kt = (bf16_t*)(lds + PL_KT); const unsigned kw[8] = {k0.x, k0.y, k0.z, k0.w, k1.x, k1.y, k1.z, k1.w};
#pragma unroll
            for (int c = 0; c < 8; ++c) { kt[(16 * p + 2 * c) * 72 + rowv] = f2bf(bflo(kw[c]) * ek); kt[(16 * p + 2 * c + 1) * 72 + rowv] = f2bf(bfhi(kw[c]) * ek); }
        } else
        { const int ol = t >> 3, p = t & 7; const int vi = dir ? 63 - ol : ol;
#pragma unroll 1
          for (int seg = 0; seg < 3; ++seg) { float acc[16];
#pragma unroll
              for (int c = 0; c < 16; ++c) acc[c] = 0.f;
#pragma unroll
              for (int j = 0; j < 5; ++j) { const unsigned char* rp = lds + PL_RAW + ((seg * 68 + ol + j) * 136 + 16 * p) * 2; const u32x4 x0 = *(const u32x4*)rp, x1 = *(const u32x4*)(rp + 16);
                  const float* wp = cw + (seg * 5 + j) * 128 + 16 * p; const f32x4 w0 = *(const f32x4*)wp, w1 = *(const f32x4*)(wp + 4), w2 = *(const f32x4*)(wp + 8), w3 = *(const f32x4*)(wp + 12);
                  acc[0] += bflo(x0.x) * w0[0]; acc[1] += bfhi(x0.x) * w0[1]; acc[2] += bflo(x0.y) * w0[2]; acc[3] += bfhi(x0.y) * w0[3];
                  acc[4] += bflo(x0.z) * w1[0]; acc[5] += bfhi(x0.z) * w1[1]; acc[6] += bflo(x0.w) * w1[2]; acc[7] += bfhi(x0.w) * w1[3];
                  acc[8] += bflo(x1.x) * w2[0]; acc[9] += bfhi(x1.x) * w2[1]; acc[10] += bflo(x1.y) * w2[2]; acc[11] += bfhi(x1.y) * w2[3];
                  acc[12] += bflo(x1.z) * w3[0]; acc[13] += bfhi(x1.z) * w3[1]; acc[14] += bflo(x1.w) * w3[2]; acc[15] += bfhi(x1.w) * w3[3]; }
              float ss = 0.f;
#pragma unroll
              for (int c = 0; c < 16; ++c) { acc[c] = silu_f(acc[c]); ss += acc[c] * acc[c]; }
              if (seg < 2) { ss += __shfl_xor(ss, 1); ss += __shfl_xor(ss, 2); ss += __shfl_xor(ss, 4); const float scl = rsqrtf(ss + 1e-6f) * (seg == 0 ? 0.08838834764831845f : 1.0f);
#pragma unroll
                  for (int c = 0; c < 16; ++c) acc[c] *= scl; }
              unsigned char* tp = lds + (seg == 0 ? PL_Q : seg == 1 ? PL_K : PL_V) + (vi * 136 + 16 * p) * 2;
              u32x4 o0, o1; o0.x = pack2(acc[0], acc[1]); o0.y = pack2(acc[2], acc[3]); o0.z = pack2(acc[4], acc[5]); o0.w = pack2(acc[6], acc[7]);
              o1.x = pack2(acc[8], acc[9]); o1.y = pack2(acc[10], acc[11]); o1.z = pack2(acc[12], acc[13]); o1.w = pack2(acc[14], acc[15]);
              *(u32x4*)tp = o0; *(u32x4*)(tp + 16) = o1;
              if (seg == 1) { const float ek = sc_ekd[vi]; bf16_t* kt = (bf16_t*)(lds + PL_KT);
#pragma unroll
                  for (int c = 0; c < 16; ++c) kt[(16 * p + c) * 72 + vi] = f2bf(acc[c] * ek); }
          } }
        raw_barrier();
        if (MODE == 0) {
#pragma unroll
            for (int j = 0; j < 6; ++j) { const int p = t + 512 * j; const int seg = p >> 10, rowv = (p >> 4) & 63, pc = p & 15; const int ol = dir ? 63 - rowv : rowv;
                *(u32x4*)(qc + (seg * 64 + ol) * 128 + pc * 8) = *(const u32x4*)(lds + (seg == 0 ? PL_Q : seg == 1 ? PL_K : PL_V) + (rowv * 136 + pc * 8) * 2); } }
        for (int idx = wv; idx < 20; idx += 8) { const int which = idx >= 10, lt = which ? idx - 10 : idx; const int ti = lt < 1 ? 0 : lt < 3 ? 1 : lt < 6 ? 2 : 3; const int tj = lt - ti * (ti + 1) / 2;
            const unsigned char* ap = lds + (which ? PL_Q : PL_K) + ((16 * ti + m) * 136 + 8 * g) * 2; const unsigned char* bp = lds + PL_K + ((16 * tj + m) * 136 + 8 * g) * 2;
            f32x4 acc = (f32x4){0.f, 0.f, 0.f, 0.f};
#pragma unroll
            for (int ks = 0; ks < 4; ++ks) acc = MFMA16(*(const bf16x8*)(ap + ks * 64), *(const bf16x8*)(bp + ks * 64), acc);
            const int j = 16 * tj + m; const float gj = sc_gc[j]; bf16_t* dst = (bf16_t*)(lds + (which ? PL_ATT : PL_AN));
#pragma unroll
            for (int e = 0; e < 4; ++e) { const int i = 16 * ti + 4 * g + e; const float dcy = __expf(fminf(sc_gc[i] - gj, 0.f));
                if (which) { dst[i * 72 + j] = f2bf(i >= j ? acc[e] * dcy : 0.f); }
                else { const float v = i > j ? sc_beta[i] * acc[e] * dcy : 0.f; dst[i * 72 + j] = f2bf(-v); if (ti == tj) LDSF(PL_A32)[ti * 260 + (4 * g + e) * 16 + m] = v; }
                if (ti != tj) dst[(16 * tj + 4 * g + e) * 72 + 16 * ti + m] = 0; }
        }
        raw_barrier();
        if (wv == 0) { const float* A = LDSF(PL_A32) + g * 260; float x[16];
            f32x4 Ar[16][4];
#pragma unroll
            for (int i = 1; i < 11; ++i)
#pragma unroll
                for (int q = 0; q < (i + 3) / 4; ++q) Ar[i][q] = *(const f32x4*)(A + i * 16 + 4 * q);
            __builtin_amdgcn_sched_barrier(0);
#pragma unroll
            for (int i = 0; i < 11; ++i) { float s = (i == m) ? 1.f : 0.f;
#pragma unroll
                for (int j = 0; j < i; ++j) s -= Ar[i][j >> 2][j & 3] * x[j];
                x[i] = s; }
            __builtin_amdgcn_sched_barrier(0);
#pragma unroll
            for (int i = 11; i < 16; ++i)
#pragma unroll
                for (int q = 0; q < (i + 3) / 4; ++q) Ar[i][q] = *(const f32x4*)(A + i * 16 + 4 * q);
            __builtin_amdgcn_sched_barrier(0);
#pragma unroll
            for (int i = 11; i < 16; ++i) { float s = (i == m) ? 1.f : 0.f;
#pragma unroll
                for (int j = 0; j < i; ++j) s -= Ar[i][j >> 2][j & 3] * x[j];
                x[i] = s; }
            bf16_t* ti_ = (bf16_t*)(lds + PL_TINV) + g * 16 * 24;
#pragma unroll
            for (int i = 0; i < 16; ++i) ti_[i * 24 + m] = f2bf(x[i]); }
        raw_barrier();
        const bool isK = wv >= 4; const int col0 = 32 * (wv & 3);
        u64_t XPq[2][2][2];
#pragma unroll
        for (int nt = 0; nt < 2; ++nt)
#pragma unroll
            for (int ks = 0; ks < 2; ++ks) { XPq[nt][ks][0] = 0ull; XPq[nt][ks][1] = 0ull; }
        { const bf16_t* src = (const bf16_t*)(lds + (isK ? PL_K : PL_V));
#pragma unroll
          for (int bi = 0; bi < 4; ++bi) { f32x4 acc[2];
#pragma unroll
              for (int nt = 0; nt < 2; ++nt)
#pragma unroll
                  for (int e = 0; e < 4; ++e) { const int i = 16 * bi + 4 * g + e; const float sc = sc_beta[i] * (isK ? sc_egc[i] : 1.f); acc[nt][e] = bf2f(src[i * 136 + col0 + 16 * nt + m]) * sc; }
              if (bi >= 1) {
#pragma unroll
                  for (int ks = 0; ks < 2; ++ks) { if (ks == 1 && bi < 3) continue;
                      const unsigned char* ap = lds + PL_AN + ((16 * bi + m) * 72 + 32 * ks + 4 * g) * 2; const bf16x8 af = mk_frag(*(const u64_t*)ap, *(const u64_t*)(ap + 32));
#pragma unroll
                      for (int nt = 0; nt < 2; ++nt) acc[nt] = MFMA16(af, mk_frag(XPq[nt][ks][0], XPq[nt][ks][1]), acc[nt]); } }
              const bf16x8 tf = mk_frag(*(const u64_t*)(lds + PL_TINV + ((bi * 16 + m) * 24 + 4 * g) * 2), 0ull);
#pragma unroll
              for (int nt = 0; nt < 2; ++nt) { const f32x4 xr = MFMA16(tf, mk_frag(pack4(acc[nt]), 0ull), ((f32x4){0.f, 0.f, 0.f, 0.f})); XPq[nt][bi >> 1][bi & 1] = pack4(xr); }
          } }
        if (!isK) {
#pragma unroll 1
            for (int mt = 0; mt < 8; ++mt) { bf16x8 kf[2];
#pragma unroll
                for (int ks = 0; ks < 2; ++ks) { const unsigned char* kp = lds + PL_KT + ((16 * mt + m) * 72 + 32 * ks + 4 * g) * 2; kf[ks] = mk_frag(*(const u64_t*)kp, *(const u64_t*)(kp + 32)); }
#pragma unroll
                for (int nt = 0; nt < 2; ++nt) { f32x4 acc = (f32x4){0.f, 0.f, 0.f, 0.f};
#pragma unroll
                    for (int ks = 0; ks < 2; ++ks) acc = MFMA16(kf[ks], mk_frag(XPq[nt][ks][0], XPq[nt][ks][1]), acc);
                    *(u64_t*)(blk + 49152 + (size_t)((((2 * wv + nt) * 4 + (mt >> 1)) * 64 + lane) * 16 + (mt & 1) * 8)) = pack4(acc); } }
#pragma unroll 1
            for (int mt = 0; mt < 4; ++mt) { bf16x8 af[2];
#pragma unroll
                for (int ks = 0; ks < 2; ++ks) { const unsigned char* ap = lds + PL_ATT + ((16 * mt + m) * 72 + 32 * ks + 4 * g) * 2; af[ks] = mk_frag(*(const u64_t*)ap, *(const u64_t*)(ap + 32)); }
#pragma unroll
                for (int nt = 0; nt < 2; ++nt) { f32x4 acc = (f32x4){0.f, 0.f, 0.f, 0.f};
#pragma unroll
                    for (int ks = 0; ks < 2; ++ks) acc = MFMA16(af[ks], mk_frag(XPq[nt][ks][0], XPq[nt][ks][1]), acc);
                    *(u64_t*)(blk + 81920 + (size_t)((((2 * wv + nt) * 2 + (mt >> 1)) * 64 + lane) * 16 + (mt & 1) * 8)) = pack4(acc); } }
        } else {
            const int ksp = wv - 4;
#pragma unroll 1
            for (int mt = 0; mt < 8; ++mt) { bf16x8 kf[2]; u64_t res[2];
#pragma unroll
                for (int ks = 0; ks < 2; ++ks) { const unsigned char* kp = lds + PL_KT + ((16 * mt + m) * 72 + 32 * ks + 4 * g) * 2; kf[ks] = mk_frag(*(const u64_t*)kp, *(const u64_t*)(kp + 32)); }
#pragma unroll
                for (int nt = 0; nt < 2; ++nt) { f32x4 acc = (f32x4){0.f, 0.f, 0.f, 0.f};
#pragma unroll
                    for (int ks = 0; ks < 2; ++ks) acc = MFMA16(mk_frag(XPq[nt][ks][0], XPq[nt][ks][1]), kf[ks], acc);
                    res[nt] = pack4(-acc); }
                u32x4 w; w.x = (unsigned)res[0]; w.y = (unsigned)(res[0] >> 32); w.z = (unsigned)res[1]; w.w = (unsigned)(res[1] >> 32);
                *(u32x4*)(blk + (size_t)(((mt * 4 + ksp) * 64 + lane) * 16)) = w; }
#pragma unroll 1
            for (int mt = 0; mt < 4; ++mt) { bf16x8 af[2]; u64_t res[2]; const float eg = sc_egc[16 * mt + m];
#pragma unroll
                for (int ks = 0; ks < 2; ++ks) { const unsigned char* ap = lds + PL_ATT + ((16 * mt + m) * 72 + 32 * ks + 4 * g) * 2; af[ks] = mk_frag(*(const u64_t*)ap, *(const u64_t*)(ap + 32)); }
#pragma unroll
                for (int nt = 0; nt < 2; ++nt) { f32x4 acc = (f32x4){0.f, 0.f, 0.f, 0.f};
#pragma unroll
                    for (int ks = 0; ks < 2; ++ks) acc = MFMA16(mk_frag(XPq[nt][ks][0], XPq[nt][ks][1]), af[ks], acc);
                    const u32x2 qw = *(const u32x2*)(lds + PL_Q + ((16 * mt + m) * 136 + 16 * (2 * ksp + nt) + 4 * g) * 2);
                    f32x4 r; r[0] = bflo(qw.x) * eg - acc[0]; r[1] = bfhi(qw.x) * eg - acc[1]; r[2] = bflo(qw.y) * eg - acc[2]; r[3] = bfhi(qw.y) * eg - acc[3];
                    res[nt] = pack4(r); }
                u32x4 w; w.x = (unsigned)res[0]; w.y = (unsigned)(res[0] >> 32); w.z = (unsigned)res[1]; w.w = (unsigned)(res[1] >> 32);
                *(u32x4*)(blk + 32768 + (size_t)(((mt * 4 + ksp) * 64 + lane) * 16)) = w; }
        }
        raw_barrier();
    }
}

constexpr int SCAN_SPLIT = 132;
static_assert(SCAN_SPLIT >= 132 && SCAN_SPLIT % 2 == 0, "P4's prep units take their q/k/v tiles from the cache written by P3's units of the opposite direction");
constexpr int CVT_SHARE0 = 0;
__device__ __forceinline__ void p3_prep(const Args& a, unsigned char* lds) {
    int cwh = -1;
    for (int u = SCAN_SPLIT * 32 - 1 - (int)blockIdx.x; u >= 0; u -= gridDim.x) prep_unit<0>(a, lds, u, cwh);
}

__device__ __forceinline__ void scan_segment(const Args& a, unsigned char* lds, const int item, const int s0, const int s1, f32x4 (&S)[8]) {
    unsigned char* ws = a.ws; const int t = threadIdx.x, lane = t & 63, wv = t >> 6; const int m = lane & 15, g = lane >> 4;
    const float* DEC = (const float*)(ws + WS_DEC); float* decs = (float*)(lds + 147456 + 64);
    const int chain = item >> 1, half = item & 1; const int h = (chain >> 1) & 7, dir = chain & 1;
    const unsigned char* cb = ws + WS_SCN + (size_t)chain * SCN_BLK;
    {
        const int n = s1 - s0, n3 = ((n + 1) / 2) * 2;
        __syncthreads();
        {
            for (int i = t; i < n; i += NTHR) decs[i] = DEC[chain * 260 + s0 + i];
            __syncthreads();
            if (wv >= 4) {
                const int lt = t - 256; u32x4 RA[18], RB[18];
#define LD_STEP(R, k_) do { const int sc_ = s0 + ((k_) < n ? (k_) : n - 1); const unsigned char* sp_ = cb + (size_t)sc_ * (32 * SCN_BLK) + lt * 16; _Pragma("unroll") for (int j_ = 0; j_ < 18; ++j_) R[j_] = *(const u32x4*)(sp_ + (j_ < 12 ? j_ * 4096 : j_ < 16 ? 49152 + half * 16384 + (j_ - 12) * 4096 : 81920 + half * 8192 + (j_ - 16) * 4096)); } while (0)
#define ST_SLOT(R, slot_) do { unsigned char* dp_ = lds + (slot_) * 73728 + lt * 16; _Pragma("unroll") for (int j_ = 0; j_ < 18; ++j_) *(u32x4*)(dp_ + j_ * 4096) = R[j_]; } while (0)
                LD_STEP(RA, 0); ST_SLOT(RA, 0); LD_STEP(RA, 1); LD_STEP(RB, 2);
                raw_barrier();
                for (int k = 0; k < n3; k += 2) {
                    ST_SLOT(RA, 1); LD_STEP(RA, k + 3);
                    raw_barrier();
                    ST_SLOT(RB, 0); LD_STEP(RB, k + 4);
                    raw_barrier();
                }
#undef LD_STEP
#undef ST_SLOT
            } else {
                const int slice = 4 * half + wv; bf16_t* O = (bf16_t*)(ws + (dir ? WS_OB : WS_OF));
                raw_barrier();
                for (int k = 0; k < n; ++k) { const int s = s0 + k;
                const unsigned char* slot = lds + (k & 1) * 73728 + lane * 16;
                u32x4 bc[4], oc[2];
#pragma unroll
                for (int q = 0; q < 4; ++q) bc[q] = *(const u32x4*)(slot + 49152 + (wv * 4 + q) * 1024);
#pragma unroll
                for (int q = 0; q < 2; ++q) oc[q] = *(const u32x4*)(slot + 65536 + (wv * 2 + q) * 1024);
                const float dec = decs[k];
                bf16x8 SB[4]; f32x4 aS[8], aO[4];
#pragma unroll
                for (int ks = 0; ks < 4; ++ks) SB[ks] = mk_frag(pack4(S[2 * ks]), pack4(S[2 * ks + 1]));
#pragma unroll
                for (int mt = 0; mt < 8; ++mt) { const unsigned w0 = (mt & 1) ? bc[mt >> 1].z : bc[mt >> 1].x, w1 = (mt & 1) ? bc[mt >> 1].w : bc[mt >> 1].y;
                    aS[mt][0] = S[mt][0] * dec + bflo(w0); aS[mt][1] = S[mt][1] * dec + bfhi(w0); aS[mt][2] = S[mt][2] * dec + bflo(w1); aS[mt][3] = S[mt][3] * dec + bfhi(w1); }
#pragma unroll
                for (int mt = 0; mt < 4; ++mt) { const unsigned w0 = (mt & 1) ? oc[mt >> 1].z : oc[mt >> 1].x, w1 = (mt & 1) ? oc[mt >> 1].w : oc[mt >> 1].y;
                    aO[mt][0] = bflo(w0); aO[mt][1] = bfhi(w0); aO[mt][2] = bflo(w1); aO[mt][3] = bfhi(w1); }
                bf16x8 FR[2][8];
#define FR_ADDR(f_) (slot + (((f_) % 12) < 8 ? ((((f_) % 12) * 4 + (f_) / 12) * 1024) : (32768 + ((((f_) % 12) - 8) * 4 + (f_) / 12) * 1024)))
#define LD_GRP(buf_, grp_) do { _Pragma("unroll") for (int q_ = 0; q_ < 8; ++q_) FR[buf_][q_] = *(const bf16x8*)FR_ADDR((grp_) * 8 + q_); } while (0)
                LD_GRP(0, 0);
#pragma unroll
                for (int gp = 0; gp < 6; ++gp) {
                    if (gp < 5) LD_GRP((gp + 1) & 1, gp + 1);
                    __builtin_amdgcn_sched_barrier(0);
#pragma unroll
                    for (int q = 0; q < 8; ++q) { const int f = gp * 8 + q; const int ks = f / 12, r = f % 12;
                        if (r < 8) aS[r] = MFMA16(FR[gp & 1][q], SB[ks], aS[r]); else aO[r - 8] = MFMA16(FR[gp & 1][q], SB[ks], aO[r - 8]); }
                    __builtin_amdgcn_sched_barrier(0);
                }
#undef LD_GRP
#undef FR_ADDR
#pragma unroll
                for (int mt = 0; mt < 8; ++mt) S[mt] = aS[mt];
                { int r0, slo, shi; chain_step_rows(chain, s, r0, slo, shi);
                  bf16_t* ob = (s >= 4) ? O + (size_t)(r0 - NCT) * 1024 : (bf16_t*)(ws + WS_ODUMP);
                  const int rs = (s >= 4) ? 1024 : 0;
#pragma unroll
                  for (int mt = 0; mt < 4; ++mt)
#pragma unroll
                      for (int e = 0; e < 4; ++e) { const int i = 16 * mt + 4 * g + e; const int rl = dir ? 63 - i : i; ob[(size_t)rl * rs + h * 128 + slice * 16 + m] = f2bf(aO[mt][e]); } }
                    raw_barrier();
                }
                for (int k = n; k < n3; ++k) raw_barrier();
            }
        }
    }
}

__device__ __forceinline__ void p4_scan(const Args& a, unsigned char* lds, int rep, const XcdBarrier& bar) {
    unsigned char* ws = a.ws; const int t = threadIdx.x, lane = t & 63, wv = t >> 6;
    unsigned* icnt = (unsigned*)(ws + WS_CTL + CTL_SCANQ) + rep * 512; volatile int* lit = (volatile int*)(lds + 147456); const unsigned xcc = xb_xcc_id() & 7u;
    __syncthreads();
    if (t == 0) { int it = -1; for (int k = 0; k < 8 && it < 0; ++k) { const unsigned x = (xcc + k) & 7u; const unsigned idx = xb_add(icnt + 64 * x, 1u); if (idx < 8u) it = (int)(x * 8u + idx); } *lit = it; }
    __syncthreads();
    const int item = *lit;
    f32x4* sv = (f32x4*)(ws + WS_SSAVE) + (size_t)(((item < 0 ? 0 : item) * 8 + wv) * 64 + lane) * 8;
    if (item >= 0) { f32x4 S[8];
#pragma unroll
        for (int i = 0; i < 8; ++i) S[i] = (f32x4){0.f, 0.f, 0.f, 0.f};
        scan_segment(a, lds, item, 0, SCAN_SPLIT, S);
#pragma unroll
        for (int i = 0; i < 8; ++i) sv[i] = S[i]; }
    { unsigned* pq = (unsigned*)(ws + WS_CTL + CTL_PREPQ);
        for (;;) {
            __syncthreads();
            if (t == 0) *lit = (int)xb_add(pq, 1u);
            __syncthreads();
            if (*lit >= 8320 - SCAN_SPLIT * 32) break; const int u = 8319 - *lit;
            { int cwh = -1; prep_unit<1>(a, lds, u, cwh); }
        } }
    xcd_barrier(bar);
    if (item >= 0) { f32x4 S[8];
#pragma unroll
        for (int i = 0; i < 8; ++i) S[i] = sv[i];
        scan_segment(a, lds, item, SCAN_SPLIT, 260, S); }
    { unsigned* cq = (unsigned*)(ws + WS_CTL + CTL_CVTQ);
        for (;;) {
            __syncthreads();
            if (t == 0) *lit = (int)xb_add(cq, 1u);
            __syncthreads();
            const int q = CVT_SHARE0 + *lit; if (q >= MOE_CVT_UNITS) break;
            moe_cvt_unit(a, (float*)lds, q);
        } }
}

__device__ __forceinline__ void p5_gdn_out(const Args& a) {
    unsigned char* ws = a.ws; const int lane = threadIdx.x & 63, wv = threadIdx.x >> 6;
    const bf16_t* OF = (const bf16_t*)(ws + WS_OF); const bf16_t* OB = (const bf16_t*)(ws + WS_OB); const bf16_t* PROJ = (const bf16_t*)(ws + WS_PROJ); bf16_t* HB = (bf16_t*)(ws + WS_HB);
    const f32x4 on0 = *(const f32x4*)(a.gdn_onorm + (lane & 15) * 8), on1 = *(const f32x4*)(a.gdn_onorm + (lane & 15) * 8 + 4);
    const float onv[8] = {on0[0], on0[1], on0[2], on0[3], on1[0], on1[1], on1[2], on1[3]};
    u32x4 ofn[2], obn[2], zwn[2]; const int stride = gridDim.x * 8;
#define P5_LOAD(n_) do { _Pragma("unroll") for (int i_ = 0; i_ < 2; ++i_) { const size_t off_ = (size_t)(n_) * 1024 + i_ * 512 + lane * 8; \
        ofn[i_] = __builtin_nontemporal_load((const u32x4*)(OF + off_)); obn[i_] = __builtin_nontemporal_load((const u32x4*)(OB + off_)); zwn[i_] = __builtin_nontemporal_load((const u32x4*)(PROJ + (size_t)(NCT + (n_)) * 4096 + 3072 + i_ * 512 + lane * 8)); } } while (0)
    if ((int)(blockIdx.x * 8 + wv) < NL) P5_LOAD(blockIdx.x * 8 + wv);
    for (int n = blockIdx.x * 8 + wv; n < NL; n += stride) {
        u32x4 of[2], ob[2], zw[2];
#pragma unroll
        for (int i = 0; i < 2; ++i) { of[i] = ofn[i]; ob[i] = obn[i]; zw[i] = zwn[i]; }
        if (n + stride < NL) P5_LOAD(n + stride);
#pragma unroll
        for (int i = 0; i < 2; ++i) { const unsigned fw[4] = {of[i].x, of[i].y, of[i].z, of[i].w}, bw[4] = {ob[i].x, ob[i].y, ob[i].z, ob[i].w}, zz[4] = {zw[i].x, zw[i].y, zw[i].z, zw[i].w};
            float o[8]; float ss = 0.f;
#pragma unroll
            for (int q = 0; q < 4; ++q) { o[2 * q] = bflo(fw[q]) + bflo(bw[q]); o[2 * q + 1] = bfhi(fw[q]) + bfhi(bw[q]); ss += o[2 * q] * o[2 * q] + o[2 * q + 1] * o[2 * q + 1]; }
            ss += __shfl_xor(ss, 1); ss += __shfl_xor(ss, 2); ss += __shfl_xor(ss, 4); ss += __shfl_xor(ss, 8);
            const float rs = rsqrtf(ss * (1.0f / 128.0f) + 1e-6f);
            u32x4 w; unsigned wq[4];
#pragma unroll
            for (int q = 0; q < 4; ++q) wq[q] = pack2(o[2 * q] * rs * onv[2 * q] * silu_f(bflo(zz[q])), o[2 * q + 1] * rs * onv[2 * q + 1] * silu_f(bfhi(zz[q])));
            w.x = wq[0]; w.y = wq[1]; w.z = wq[2]; w.w = wq[3];
            *(u32x4*)(HB + (size_t)n * 1024 + i * 512 + lane * 8) = w; }
    }
#undef P5_LOAD
}

template <int L> __device__ __forceinline__ void p7_router(const Args& a, unsigned char* lds) {
    unsigned char* ws = a.ws; const int t = threadIdx.x, lane = t & 63, wv = t >> 6; const int m = lane & 15, g = lane >> 4;
    const float* MOD = (const float*)(ws + WS_MOD) + (size_t)L * 3 * 6144; const float* X0 = (const float*)(ws + WS_X0); bf16_t* HB = (bf16_t*)(ws + WS_HB);
    int* TOPE = (int*)(ws + WS_TOPE); float* TOPW = (float*)(ws + WS_TOPW); int* SLOT = (int*)(ws + WS_SLOT); int* CNT = (int*)(ws + WS_CTL + CTL_CNT) + L * 32;
    const float* gf = a.g_ffn + L * 1024; const float* br = a.moe_b_router + L * 32; const bf16_t* WT = (const bf16_t*)(ws + WS_WRT) + (size_t)L * 2 * 32768;
    float* gms = LDSF(0), * shv = LDSF(4096);
    int* lcnt = (int*)(lds + 65536); int* gbase = lcnt + 32; int* tokE = gbase + 32; int* tokS = tokE + 512; float* tokW = (float*)(tokS + 512);
    for (int u = blockIdx.x; u < NL / 128; u += gridDim.x) {
        const int b = (u * 128) >> 14; const float* mv = MOD + b * 6144;
        if (t < 32) lcnt[t] = 0;
        { float gv_[2], sv_[2], hv_[2];
#pragma unroll
          for (int j = 0; j < 2; ++j) { const int i = t + 512 * j; gv_[j] = gf[i]; sv_[j] = mv[4096 + i]; hv_[j] = mv[3072 + i]; }
#pragma unroll
          for (int j = 0; j < 2; ++j) { const int i = t + 512 * j; gms[i] = gv_[j] * (1.0f + sv_[j]); shv[i] = hv_[j]; } }
        __syncthreads();
        const int n0 = u * 128 + wv * 16;
        float myr = 0.f;
        f32x4 xn[2][4];
#define P7_LOAD(tt_) do { _Pragma("unroll") for (int tk_ = 0; tk_ < 2; ++tk_) { const float* xp_ = X0 + (size_t)(n0 + (tt_) + tk_) * 1024 + lane * 8; \
            _Pragma("unroll") for (int i_ = 0; i_ < 2; ++i_) { xn[tk_][2 * i_] = *(const f32x4*)(xp_ + i_ * 512); xn[tk_][2 * i_ + 1] = *(const f32x4*)(xp_ + i_ * 512 + 4); } } } while (0)
        P7_LOAD(0);
#pragma unroll 1
        for (int tt = 0; tt < 16; tt += 2) { f32x4 xv[2][4];
#pragma unroll
            for (int tk = 0; tk < 2; ++tk)
#pragma unroll
                for (int i = 0; i < 4; ++i) xv[tk][i] = xn[tk][i];
            if (tt + 2 < 16) P7_LOAD(tt + 2);
#pragma unroll
            for (int tk = 0; tk < 2; ++tk) { const int n = n0 + tt + tk; float ss = 0.f;
#pragma unroll
                for (int i = 0; i < 4; ++i) ss += xv[tk][i][0] * xv[tk][i][0] + xv[tk][i][1] * xv[tk][i][1] + xv[tk][i][2] * xv[tk][i][2] + xv[tk][i][3] * xv[tk][i][3];
                ss = wave_sum(ss); const float rstd = rsqrtf(ss * (1.0f / 1024.0f) + 1e-6f); if (lane == tt + tk) myr = rstd;
#pragma unroll
                for (int i = 0; i < 2; ++i) { const int c = i * 512 + lane * 8; const f32x4 gm0 = *(const f32x4*)(gms + c), gm1 = *(const f32x4*)(gms + c + 4), sh0 = *(const f32x4*)(shv + c), sh1 = *(const f32x4*)(shv + c + 4);
                    const f32x4 h0 = xv[tk][2 * i] * rstd * gm0 + sh0, h1 = xv[tk][2 * i + 1] * rstd * gm1 + sh1;
                    u32x4 w; w.x = pg8::cvt_pk_bf16(h0[0], h0[1]); w.y = pg8::cvt_pk_bf16(h0[2], h0[3]); w.z = pg8::cvt_pk_bf16(h1[0], h1[1]); w.w = pg8::cvt_pk_bf16(h1[2], h1[3]);
                    *(u32x4*)(HB + (size_t)n * 1024 + c) = w; } } }
#undef P7_LOAD
        const float rst = __shfl(myr, m);
        f32x4 acc[2]; acc[0] = (f32x4){0.f, 0.f, 0.f, 0.f}; acc[1] = acc[0];
        const float* xp = X0 + (size_t)(n0 + m) * 1024 + 8 * g; const bf16_t* wp = WT + (size_t)m * 1024 + 8 * g;
#pragma unroll 1
        for (int ks0 = 0; ks0 < 32; ks0 += 4) { f32x4 xa[4][2]; bf16x8 bh[4][2], bl[4][2];
#pragma unroll
            for (int j = 0; j < 4; ++j) { const int ks = ks0 + j; xa[j][0] = __builtin_nontemporal_load((const f32x4*)(xp + 32 * ks)); xa[j][1] = __builtin_nontemporal_load((const f32x4*)(xp + 32 * ks + 4));
#pragma unroll
                for (int nt = 0; nt < 2; ++nt) { bh[j][nt] = *(const bf16x8*)(wp + (size_t)(16 * nt) * 1024 + 32 * ks); bl[j][nt] = *(const bf16x8*)(wp + 32768 + (size_t)(16 * nt) * 1024 + 32 * ks); } }
#pragma unroll
            for (int j = 0; j < 4; ++j) { const int ks = ks0 + j; const f32x4 x0 = xa[j][0], x1 = xa[j][1];
                const f32x4 g0 = *(const f32x4*)(gms + 32 * ks + 8 * g), g1 = *(const f32x4*)(gms + 32 * ks + 8 * g + 4), s0 = *(const f32x4*)(shv + 32 * ks + 8 * g), s1 = *(const f32x4*)(shv + 32 * ks + 8 * g + 4);
                const f32x4 h0 = x0 * rst * g0 + s0, h1 = x1 * rst * g1 + s1;
                u32x4 hi, lo; hi.x = pg8::cvt_pk_bf16(h0[0], h0[1]); hi.y = pg8::cvt_pk_bf16(h0[2], h0[3]); hi.z = pg8::cvt_pk_bf16(h1[0], h1[1]); hi.w = pg8::cvt_pk_bf16(h1[2], h1[3]);
                lo.x = pg8::cvt_pk_bf16(h0[0] - bflo(hi.x), h0[1] - bfhi(hi.x)); lo.y = pg8::cvt_pk_bf16(h0[2] - bflo(hi.y), h0[3] - bfhi(hi.y));
                lo.z = pg8::cvt_pk_bf16(h1[0] - bflo(hi.z), h1[1] - bfhi(hi.z)); lo.w = pg8::cvt_pk_bf16(h1[2] - bflo(hi.w), h1[3] - bfhi(hi.w));
                const bf16x8 ahi = __builtin_bit_cast(bf16x8, hi), alo = __builtin_bit_cast(bf16x8, lo);
#pragma unroll
                for (int nt = 0; nt < 2; ++nt) { acc[nt] = MFMA16(ahi, bh[j][nt], acc[nt]); acc[nt] = MFMA16(ahi, bl[j][nt], acc[nt]); acc[nt] = MFMA16(alo, bh[j][nt], acc[nt]); } } }
        const float b0 = br[m], b1 = br[16 + m];
#pragma unroll
        for (int e = 0; e < 4; ++e) { float v0 = acc[0][e] + b0, v1 = acc[1][e] + b1; int selE[4]; float selV[4];
#pragma unroll
            for (int k = 0; k < 4; ++k) { float bv; int bi; if (v1 > v0) { bv = v1; bi = 16 + m; } else { bv = v0; bi = m; }
#pragma unroll
                for (int o = 1; o <= 8; o <<= 1) { const float ov = __shfl_xor(bv, o); const int oi = __shfl_xor(bi, o); if (ov > bv || (ov == bv && oi < bi)) { bv = ov; bi = oi; } }
                selE[k] = bi; selV[k] = bv; if (bi == m) v0 = -3.0e38f; if (bi == 16 + m) v1 = -3.0e38f; }
            if (m == 0) { const int tl = wv * 16 + 4 * g + e; const float e1 = __expf(selV[1] - selV[0]), e2 = __expf(selV[2] - selV[0]), e3 = __expf(selV[3] - selV[0]); const float inv = 1.f / (1.f + e1 + e2 + e3);
                const float wk[4] = {inv, e1 * inv, e2 * inv, e3 * inv};
#pragma unroll
                for (int k = 0; k < 4; ++k) { tokE[tl * 4 + k] = selE[k]; tokW[tl * 4 + k] = wk[k]; tokS[tl * 4 + k] = atomicAdd(&lcnt[selE[k]], 1); } } }
        __syncthreads();
        if (t < 32) gbase[t] = atomicAdd(&CNT[t], lcnt[t]);
        __syncthreads();
        { const int tl = t >> 2; const int n = u * 128 + tl; const int e = tokE[t]; const int sl = gbase[e] + tokS[t]; TOPE[(size_t)n * 4 + (t & 3)] = e; TOPW[(size_t)n * 4 + (t & 3)] = tokW[t]; SLOT[(size_t)n * 4 + (t & 3)] = sl;
          ((int*)(ws + WS_ROWTOK))[(size_t)e * NL + sl] = n; }
        __syncthreads();
    }
}

template <int L> __device__ __forceinline__ void p11_combine(const Args& a, unsigned char* lds) {
    unsigned char* ws = a.ws; const int lane = threadIdx.x & 63, wv = threadIdx.x >> 6;
    const float* MOD = (const float*)(ws + WS_MOD); float* X0 = (float*)(ws + WS_X0); bf16_t* HB = (bf16_t*)(ws + WS_HB);
    const bf16_t* YS = (const bf16_t*)(ws + WS_XS); const int* TOPE = (const int*)(ws + WS_TOPE); const int* SLOT = (const int*)(ws + WS_SLOT); const float* TOPW = (const float*)(ws + WS_TOPW);
    moe_build_tables((const int*)(ws + WS_CTL + CTL_CNT) + L * 32, lds); const MoeTab* T = (const MoeTab*)(lds + MT_OFF);
    const int stride = gridDim.x * 8; const int n00 = blockIdx.x * 8 + wv;
    f32x4 gmv[4];
#pragma unroll
    for (int i = 0; i < 4; ++i) gmv[i] = *(const f32x4*)((L == 0 ? a.g_mix + 1024 : a.g_final) + i * 256 + lane * 4);
    int rowsN[2][4]; float wkN[2][4];
#define P11_IDX(nn_, tk_) do { _Pragma("unroll") for (int k_ = 0; k_ < 4; ++k_) { const int nq_ = (nn_) < NL ? (nn_) : NL - 1; rowsN[tk_][k_] = T->rb[TOPE[(size_t)nq_ * 4 + k_]] + SLOT[(size_t)nq_ * 4 + k_]; wkN[tk_][k_] = TOPW[(size_t)nq_ * 4 + k_]; } } while (0)
    P11_IDX(n00, 0); P11_IDX(n00 + stride, 1);
    for (int n0 = n00; n0 < NL; n0 += 2 * stride) {
        int rows[2][4]; float wk[2][4];
#pragma unroll
        for (int tk = 0; tk < 2; ++tk)
#pragma unroll
            for (int k = 0; k < 4; ++k) { rows[tk][k] = rowsN[tk][k]; wk[tk][k] = wkN[tk][k]; }
        u32x2 yw[2][4][4]; f32x4 xin[2][4];
#pragma unroll
        for (int tk = 0; tk < 2; ++tk) { const int n = n0 + tk * stride < NL ? n0 + tk * stride : NL - 1;
#pragma unroll
            for (int i = 0; i < 4; ++i) { const int c = i * 256 + lane * 4;
#pragma unroll
                for (int k = 0; k < 4; ++k) yw[tk][i][k] = __builtin_nontemporal_load((const u32x2*)(YS + (size_t)rows[tk][k] * 1024 + c));
                xin[tk][i] = __builtin_nontemporal_load((const f32x4*)(X0 + (size_t)n * 1024 + c)); } }
        P11_IDX(n0 + 2 * stride, 0); P11_IDX(n0 + 3 * stride, 1);
#pragma unroll
        for (int tk = 0; tk < 2; ++tk) { const int n = n0 + tk * stride; if (n >= NL) break;
            const int b = n >> 14; const float* mvL = MOD + ((size_t)L * 3 + b) * 6144; const float* mv1 = MOD + ((size_t)3 + b) * 6144;
            f32x4 g2v[4], shv_[4], scv_[4];
#pragma unroll
            for (int i = 0; i < 4; ++i) { const int c = i * 256 + lane * 4; g2v[i] = *(const f32x4*)(mvL + 5 * 1024 + c); if (L == 0) { shv_[i] = *(const f32x4*)(mv1 + c); scv_[i] = *(const f32x4*)(mv1 + 1024 + c); } }
            f32x4 xv[4]; float ss = 0.f;
#pragma unroll
            for (int i = 0; i < 4; ++i) { const int c = i * 256 + lane * 4; f32x4 y = (f32x4){0.f, 0.f, 0.f, 0.f};
#pragma unroll
                for (int k = 0; k < 4; ++k) { const u32x2 w = yw[tk][i][k]; const float wq = wk[tk][k]; y[0] += wq * bflo(w.x); y[1] += wq * bfhi(w.x); y[2] += wq * bflo(w.y); y[3] += wq * bfhi(w.y); }
                const f32x4 g2 = g2v[i]; xv[i] = xin[tk][i] + g2 * y;
                ss += xv[i][0] * xv[i][0] + xv[i][1] * xv[i][1] + xv[i][2] * xv[i][2] + xv[i][3] * xv[i][3]; }
            ss = wave_sum(ss); const float rstd = rsqrtf(ss * (1.0f / 1024.0f) + 1e-6f);
            if (L == 0) {
#pragma unroll
                for (int i = 0; i < 4; ++i) { const int c = i * 256 + lane * 4; *(f32x4*)(X0 + (size_t)n * 1024 + c) = xv[i];
                    const f32x4 gm = gmv[i], sh = shv_[i], sc = scv_[i];
                    const f32x4 hv = xv[i] * rstd * gm * (sc + 1.0f) + sh; u32x2 w; w.x = pack2(hv[0], hv[1]); w.y = pack2(hv[2], hv[3]); *(u32x2*)(HB + (size_t)n * 1024 + c) = w; }
            } else {
#pragma unroll
                for (int i = 0; i < 4; ++i) { const int c = i * 256 + lane * 4; const f32x4 gm = gmv[i]; __builtin_nontemporal_store(xv[i] * rstd * gm, (f32x4*)(a.out + (size_t)n * 1024 + c)); }
            }
        }
    }
#undef P11_IDX
}

__device__ __forceinline__ void fnet_id_frags(int lane, bf16x8& idlo, bf16x8& idhi) {
    const int m = lane & 15, g = lane >> 4;
#pragma unroll
    for (int j = 0; j < 8; ++j) { const int k = 8 * g + j; idlo[j] = (short)(k == m ? 0x3F80 : 0); idhi[j] = (short)(k == 16 + m ? 0x3F80 : 0); }
}
constexpr int FN_STG = 65536;
__device__ __forceinline__ void p12_f1(const Args& a, unsigned char* lds) {
    unsigned char* ws = a.ws; const int t = threadIdx.x, lane = t & 63, wv = t >> 6; const int m = lane & 15, g = lane >> 4;
    const bf16_t* HB = (const bf16_t*)(ws + WS_HB); bf16_t* YR = (bf16_t*)(ws + WS_YR); bf16_t* YI = (bf16_t*)(ws + WS_YI); const float* TW = (const float*)(ws + WS_TW);
    { u32x4 ftv[8];
#pragma unroll
      for (int j = 0; j < 8; ++j) ftv[j] = ((const u32x4*)(ws + WS_FT))[t + 512 * j];
#pragma unroll
      for (int j = 0; j < 8; ++j) ((u32x4*)lds)[t + 512 * j] = ftv[j]; }
    __syncthreads();
    bf16x8 idlo, idhi; fnet_id_frags(lane, idlo, idhi);
    const f32x4 z4 = (f32x4){0.f, 0.f, 0.f, 0.f}; bf16_t* stg = (bf16_t*)(lds + FN_STG);
    bf16x8 af[8];
#define F1_LOAD(u_) do { const int b_ = (u_) >> 9, n2_ = ((u_) >> 2) & 127, cb_ = (u_) & 3; const bf16_t* hp_ = HB + ((size_t)(b_ * SEQ + n2_ + 128 * m) * 1024 + cb_ * 256 + 32 * wv + 8 * g); \
        _Pragma("unroll") for (int mt_ = 0; mt_ < 8; ++mt_) af[mt_] = __builtin_nontemporal_load((const bf16x8*)(hp_ + (size_t)(128 * 16 * mt_) * 1024)); } while (0)
    if ((int)blockIdx.x < 1024) F1_LOAD((int)blockIdx.x);
    for (int u = blockIdx.x; u < 1024; u += gridDim.x) {
        const int b = u >> 9, n2 = (u >> 2) & 127, cb = u & 3; const int cw0 = cb * 256 + 32 * wv;
        u64_t pk2[2][8];
#pragma unroll
        for (int mt = 0; mt < 8; ++mt) { pk2[0][mt] = pack4(MFMA16(af[mt], idlo, z4)); pk2[1][mt] = pack4(MFMA16(af[mt], idhi, z4)); }
        if (u + (int)gridDim.x < 1024) F1_LOAD(u + (int)gridDim.x);
#pragma unroll 1
        for (int qh = 0; qh < 2; ++qh) {
            f32x4 twa[4], twb[4];
#pragma unroll
            for (int q = 0; q < 4; ++q) { const int kq = 16 * (qh * 4 + q) + 4 * g; twa[q] = *(const f32x4*)(TW + (size_t)(n2 * 128 + kq) * 2); twb[q] = *(const f32x4*)(TW + (size_t)(n2 * 128 + kq) * 2 + 4); }
#pragma unroll
            for (int nt = 0; nt < 2; ++nt) { u64_t pk[8];
#pragma unroll
                for (int mt = 0; mt < 8; ++mt) pk[mt] = pk2[nt][mt];
                f32x4 yc[4], ys[4];
#pragma unroll
                for (int q = 0; q < 4; ++q) { yc[q] = z4; ys[q] = z4; }
#pragma unroll
                for (int ks = 0; ks < 4; ++ks) { asm volatile("" ::: "memory"); const bf16x8 bop = mk_frag(pk[2 * ks], pk[2 * ks + 1]);
#pragma unroll
                    for (int q = 0; q < 4; ++q) { const unsigned char* fp = lds + (((qh * 4 + q) * 4 + ks) * 64 + lane) * 16;
                        yc[q] = MFMA16(*(const bf16x8*)fp, bop, yc[q]); ys[q] = MFMA16(*(const bf16x8*)(fp + 32768), bop, ys[q]); } }
#pragma unroll
                for (int q = 0; q < 4; ++q) { const f32x4 t01 = twa[q], t23 = twb[q];
                    const float tc[4] = {t01[0], t01[2], t23[0], t23[2]}, ts[4] = {t01[1], t01[3], t23[1], t23[3]};
#pragma unroll
                    for (int e = 0; e < 4; ++e) { const float ar = yc[q][e], ai = -ys[q][e]; const int so = (16 * q + 4 * g + e) * 256 + 32 * wv + 16 * nt + m;
                        stg[so] = f2bf(ar * tc[e] + ai * ts[e]); stg[16384 + so] = f2bf(ai * tc[e] - ar * ts[e]); } }
            }
            __syncthreads();
#pragma unroll
            for (int j = 0; j < 8; ++j) { const int p = t + 512 * j; const int pl = p >> 11, row = (p >> 5) & 63, c16 = p & 31;
                bf16_t* dst = (pl ? YI : YR) + ((size_t)(b * 128 + 64 * qh + row) * 128 + n2) * 1024 + cb * 256 + c16 * 8;
                *(u32x4*)dst = *(const u32x4*)(lds + FN_STG + (size_t)p * 16); }
            __syncthreads();
        }
    }
#undef F1_LOAD
    __syncthreads();
}
__device__ __forceinline__ void p13_f2(const Args& a, unsigned char* lds) {
    unsigned char* ws = a.ws; const int t = threadIdx.x, lane = t & 63, wv = t >> 6; const int m = lane & 15, g = lane >> 4;
    const bf16_t* YR = (const bf16_t*)(ws + WS_YR); const bf16_t* YI = (const bf16_t*)(ws + WS_YI); bf16_t* XC = (bf16_t*)(ws + WS_XCAT);
    { u32x4 ftv[8];
#pragma unroll
      for (int j = 0; j < 8; ++j) ftv[j] = ((const u32x4*)(ws + WS_FT))[t + 512 * j];
#pragma unroll
      for (int j = 0; j < 8; ++j) ((u32x4*)lds)[t + 512 * j] = ftv[j]; }
    __syncthreads();
    bf16x8 idlo, idhi; fnet_id_frags(lane, idlo, idhi);
    const f32x4 z4 = (f32x4){0.f, 0.f, 0.f, 0.f}; bf16_t* stg = (bf16_t*)(lds + FN_STG);
    bf16x8 afr[8], afi[8];
#define F2_LOAD(u_) do { const int b_ = (u_) >> 9, k1_ = ((u_) >> 2) & 127, cb_ = (u_) & 3; const size_t ro_ = ((size_t)(b_ * 128 + k1_) * 128 + m) * 1024 + cb_ * 256 + 32 * wv + 8 * g; \
        _Pragma("unroll") for (int mt_ = 0; mt_ < 8; ++mt_) { afr[mt_] = __builtin_nontemporal_load((const bf16x8*)(YR + ro_ + (size_t)(16 * mt_) * 1024)); afi[mt_] = __builtin_nontemporal_load((const bf16x8*)(YI + ro_ + (size_t)(16 * mt_) * 1024)); } } while (0)
    if ((int)blockIdx.x < 1024) F2_LOAD((int)blockIdx.x);
    for (int u = blockIdx.x; u < 1024; u += gridDim.x) {
        const int b = u >> 9, k1 = (u >> 2) & 127, cb = u & 3; const int cw0 = cb * 256 + 32 * wv;
        u64_t pr2[2][8], pi2[2][8];
#pragma unroll
        for (int mt = 0; mt < 8; ++mt) { pr2[0][mt] = pack4(MFMA16(afr[mt], idlo, z4)); pr2[1][mt] = pack4(MFMA16(afr[mt], idhi, z4)); pi2[0][mt] = pack4(MFMA16(afi[mt], idlo, z4)); pi2[1][mt] = pack4(MFMA16(afi[mt], idhi, z4)); }
        if (u + (int)gridDim.x < 1024) F2_LOAD(u + (int)gridDim.x);
#pragma unroll 1
        for (int qh = 0; qh < 2; ++qh) {
#pragma unroll
            for (int nt = 0; nt < 2; ++nt) { u64_t pr[8], pi[8];
#pragma unroll
                for (int mt = 0; mt < 8; ++mt) { pr[mt] = pr2[nt][mt]; pi[mt] = pi2[nt][mt]; }
                f32x4 xr[4], xi[4], xn[4];
#pragma unroll
                for (int q = 0; q < 4; ++q) { xr[q] = z4; xi[q] = z4; xn[q] = z4; }
#pragma unroll
                for (int ks = 0; ks < 4; ++ks) { asm volatile("" ::: "memory"); const bf16x8 br = mk_frag(pr[2 * ks], pr[2 * ks + 1]), bi = mk_frag(pi[2 * ks], pi[2 * ks + 1]);
#pragma unroll
                    for (int q = 0; q < 4; ++q) { const unsigned char* fp = lds + (((qh * 4 + q) * 4 + ks) * 64 + lane) * 16; const bf16x8 cf = *(const bf16x8*)fp, sf = *(const bf16x8*)(fp + 32768);
                        xr[q] = MFMA16(cf, br, xr[q]); xr[q] = MFMA16(sf, bi, xr[q]); xi[q] = MFMA16(cf, bi, xi[q]); xn[q] = MFMA16(sf, br, xn[q]); } }
#pragma unroll
                for (int q = 0; q < 4; ++q)
#pragma unroll
                    for (int e = 0; e < 4; ++e) { const int so = (16 * q + 4 * g + e) * 256 + 32 * wv + 16 * nt + m; stg[so] = f2bf(xr[q][e]); stg[16384 + so] = f2bf(xi[q][e] - xn[q][e]); }
            }
            __syncthreads();
#pragma unroll
            for (int j = 0; j < 8; ++j) { const int p = t + 512 * j; const int pl = p >> 11, row = (p >> 5) & 63, c16 = p & 31;
                bf16_t* dst = XC + ((size_t)b * SEQ + k1 + 128 * (64 * qh + row)) * 2048 + pl * 1024 + cb * 256 + c16 * 8;
                *(u32x4*)dst = *(const u32x4*)(lds + FN_STG + (size_t)p * 16); }
            __syncthreads();
        }
    }
#undef F2_LOAD
    __syncthreads();
}

constexpr int NPHASE = 20;
#ifndef REP_MASK
#define REP_MASK 0ull
#endif
#define PHASE_IF(k) for (int r_ = 0, n_ = IN(k) ? 1 + (int)(((unsigned long long)(REP_MASK) >> (k)) & 1ull) : 0; r_ < n_; (++r_ < n_) ? xcd_barrier(bar) : (void)0)
template <int L> __device__ __forceinline__ void moe_phases(const Args& args, unsigned char* lds, int lo, int hi, int base, const XcdBarrier& bar) {
#define IN(k) (lo <= (k) && (k) < hi)
#define SEAM(k) do { if (IN(k) && IN((k) + 1)) xcd_barrier(bar); } while (0)
    unsigned char* ws = args.ws;
    PHASE_IF(base + 0) p7_router<L>(args, lds);
    SEAM(base + 0);
    PHASE_IF(base + 2) {
        const int* CNT = (const int*)(ws + WS_CTL + CTL_CNT) + L * 32; moe_build_tables(CNT, lds);
        pg8::Gemm g{(const bf16_t*)(ws + WS_HB), (const bf16_t*)(ws + WS_BTGU) + (size_t)L * 32 * 2048 * 1024, MAXROWS, 2048, 1024};
        MoeOrder S{(int)gridDim.x, (int)blockIdx.x, 8, (const MoeTab*)(lds + MT_OFF), (const int*)(lds + RT_OFF), 2048u, 0};
        moe_build_rowtab(S, (const int*)(ws + WS_ROWTOK), lds);
        EpiGLU E{(bf16_t*)(ws + WS_ACT), args.moe_b_gu + (size_t)L * 32 * 2048};
        pg8::gemm_phase_ga<EpiGLU, MoeOrder, false>((PG8_LAS unsigned char*)lds, g, S, E, nullptr);
    }
    SEAM(base + 2);
    PHASE_IF(base + 3) {
        const int* CNT = (const int*)(ws + WS_CTL + CTL_CNT) + L * 32; moe_build_tables(CNT, lds);
        pg8::Gemm g{(const bf16_t*)(ws + WS_ACT), (const bf16_t*)(ws + WS_BTDN) + (size_t)L * 32 * 1024 * 1024, MAXROWS, 1024, 1024};
        MoeOrderR S{(int)gridDim.x, (int)blockIdx.x, 4, (const MoeTab*)(lds + MT_OFF), (const int*)(ws + WS_ROWTOK), 2048u, 0};
        EpiDown E{(bf16_t*)(ws + WS_XS), args.moe_b_down + (size_t)L * 32 * 1024};
        pg8::gemm_phase<EpiDown, MoeOrderR, false>((PG8_LAS unsigned char*)lds, g, S, E, nullptr);
    }
    SEAM(base + 3);
    PHASE_IF(base + 4) p11_combine<L>(args, lds);
    SEAM(base + 4);
#undef SEAM
#undef IN
}

__global__ void __launch_bounds__(NTHR, 2) mk_fwd(Args args) {
    extern __shared__ __attribute__((aligned(16))) unsigned char lds[];
    unsigned char* ws = args.ws;
    const int lo = args.ph_lo, hi = args.ph_hi;
#define IN(k) (lo <= (k) && (k) < hi)
#define SEAM(k) do { if (IN(k) && IN((k) + 1)) xcd_barrier(bar); } while (0)
    volatile LAS unsigned* xbw = (volatile LAS unsigned*)(lds + LDS_BYTES - 16);
    if (threadIdx.x < 4) xbw[threadIdx.x] = 0u;
    __syncthreads();
    XcdBarrier bar; bar.bar = (unsigned*)(ws + WS_CTL); bar.x = 0; bar.st = xbw;
    if (hi - lo > 1) bar = xcd_barrier_post((unsigned*)(ws + WS_CTL), xbw);
    PHASE_IF(0) p0_prologue(args, lds);
    SEAM(0);
    PHASE_IF(1) p1_embed(args);
    SEAM(1);
    PHASE_IF(2) {
        pg8::Gemm g{(const bf16_t*)(ws + WS_HB), (const bf16_t*)(ws + WS_BTIN), TALL, GINP, 1024};
        pg8::StaticOrder S; S.init(TALL, GINP, (int)gridDim.x, (int)blockIdx.x);
        EpiProj E{(bf16_t*)(ws + WS_PROJ), (float*)(ws + WS_GATES)};
        pg8::gemm_phase<EpiProj, pg8::StaticOrder, false>((PG8_LAS unsigned char*)lds, g, S, E, nullptr);
    }
    SEAM(2);
    PHASE_IF(3) p3_prep(args, lds);
    SEAM(3);
    PHASE_IF(4) p4_scan(args, lds, r_, bar);
    SEAM(4);
    PHASE_IF(5) p5_gdn_out(args);
    SEAM(5);
    PHASE_IF(6) {
        pg8::Gemm g{(const bf16_t*)(ws + WS_HB), (const bf16_t*)(ws + WS_BTOUT), NL, 1024, 1024};
        pg8::StaticOrder S; S.init(NL, 1024, (int)gridDim.x, (int)blockIdx.x);
        EpiResid0 E{(float*)(ws + WS_X0), args.x, (const float*)(ws + WS_POSR), (const float*)(ws + WS_POSC), (const float*)(ws + WS_MOD) + 2048};
        pg8::gemm_phase<EpiResid0, pg8::StaticOrder, false>((PG8_LAS unsigned char*)lds, g, S, E, nullptr);
    }
    SEAM(6);
    moe_phases<0>(args, lds, lo, hi, 7, bar);
    PHASE_IF(12) p12_f1(args, lds);
    SEAM(12);
    PHASE_IF(13) p13_f2(args, lds);
    SEAM(13);
    PHASE_IF(14) {
        pg8::Gemm g{(const bf16_t*)(ws + WS_XCAT), (const bf16_t*)(ws + WS_BTFN), NL, 1024, 2048};
        pg8::StaticOrder S; S.init(NL, 1024, (int)gridDim.x, (int)blockIdx.x);
        EpiResid E{(float*)(ws + WS_X0), (const float*)(ws + WS_MOD) + 3 * 6144 + 2048};
        pg8::gemm_phase<EpiResid, pg8::StaticOrder, false>((PG8_LAS unsigned char*)lds, g, S, E, nullptr);
    }
    SEAM(14);
    moe_phases<1>(args, lds, lo, hi, 15, bar);
#undef SEAM
#undef IN
}

extern "C" void kernel_launch(void* const* d_in, const int* in_sizes, int n_in, void* d_out, int out_size, void* d_ws, size_t ws_size, hipStream_t stream) {
    static int grid = 0;
    if (grid == 0) {
        int dev = 0, cus = 0;
        if (hipGetDevice(&dev) != hipSuccess || hipDeviceGetAttribute(&cus, hipDeviceAttributeMultiprocessorCount, dev) != hipSuccess) { fprintf(stderr, "kernel_launch: device query failed\n"); grid = -1; return; }
        if (hipFuncSetAttribute((const void*)mk_fwd, hipFuncAttributeMaxDynamicSharedMemorySize, LDS_BYTES) != hipSuccess) { fprintf(stderr, "kernel_launch: hipFuncSetAttribute failed\n"); grid = -1; return; }
        if (n_in != 22 || ws_size < WS_END) { fprintf(stderr, "kernel_launch: unexpected n_in %d or ws_size %zu < %zu\n", n_in, ws_size, (size_t)WS_END); grid = -1; return; }
        grid = cus;
    }
    if (grid < 0) return;
    (void)hipMemsetAsync((char*)d_ws + WS_CTL, 0, CTL_BYTES, stream);
    Args a{};
    const float** fp = (const float**)&a;
    for (int i = 0; i < 22; ++i) fp[i] = (const float*)d_in[i];
    a.out = (float*)d_out; a.ws = (unsigned char*)d_ws;
#if defined(MK_PER_PHASE)
    for (int ph = 0; ph < NPHASE; ++ph) { a.ph_lo = ph; a.ph_hi = ph + 1; hipLaunchKernelGGL(mk_fwd, dim3(grid), dim3(NTHR), LDS_BYTES, stream, a); }
#else
    a.ph_lo = 0; a.ph_hi = NPHASE; hipLaunchKernelGGL(mk_fwd, dim3(grid), dim3(NTHR), LDS_BYTES, stream, a);
#endif
}
```
